# Optimizing an MI355X kernel written in HIP

```python
import jax, jax.numpy as jnp
from jax import lax
import numpy as np

D_MODEL = 1024
BATCH = 2
SEQ = 8192
DEPTH = 1

CHUNK = 64
QBLOCK = 128
SB_HEADS = 8
SB_HEAD_DIM = 64
SB_WIDTH = SB_HEADS * SB_HEAD_DIM
HG_HEADS = 8
HG_KDIM = 64
HG_VDIM = 64
HG_WIDTH = HG_HEADS * HG_KDIM
HG_VWIDTH = HG_HEADS * HG_VDIM
N_BRANCHES = 2
N_GROUPS = 4
EXPERTS_PER_GROUP = 4
N_EXPERTS = N_GROUPS * EXPERTS_PER_GROUP
TOP_K_INNER = 2
D_EXPERT = 512
IN_COLS = 3 * SB_WIDTH + 2 * HG_WIDTH + 2 * HG_VWIDTH + N_BRANCHES * D_MODEL
EPS = 1e-6

kernel_name = 'hybrid_stickbreak_hgrn2_hmoe'


def rmsnorm(x, g):
    xf = x.astype(jnp.float32)
    var = jnp.mean(xf * xf, axis=-1, keepdims=True)
    return (xf * lax.rsqrt(var + EPS) * g.astype(jnp.float32)).astype(x.dtype)


def stick_breaking_attention(q, k, v):
    b, h, s, dh = q.shape
    nb = s // QBLOCK
    scale = dh ** -0.5
    key_pos = jnp.arange(s)
    q_blocks = q.reshape(b, h, nb, QBLOCK, dh).transpose(2, 0, 1, 3, 4)

    def one_block(args):
        q_blk, blk = args
        z = jnp.einsum('bhqd,bhkd->bhqk', q_blk, k, preferred_element_type=jnp.float32) * scale
        q_pos = blk * QBLOCK + jnp.arange(QBLOCK)
        mask = key_pos[None, :] < q_pos[:, None]
        log_beta = jax.nn.log_sigmoid(z)
        log_keep = jnp.where(mask, jax.nn.log_sigmoid(-z), 0.0)
        later = jnp.concatenate([log_keep[..., 1:], jnp.zeros_like(log_keep[..., :1])], axis=-1)
        log_survive = lax.cumsum(later, axis=3, reverse=True)
        a = jnp.where(mask, jnp.exp(log_beta + log_survive), 0.0)
        return jnp.einsum('bhqk,bhkd->bhqd', a.astype(v.dtype), v)

    out = lax.map(one_block, (q_blocks, jnp.arange(nb)))
    return out.transpose(1, 2, 0, 3, 4).reshape(b, h, s, dh)


def hgrn2_chunk_scan(q, k, log_f, v):
    b, s, h, dk = q.shape
    dv = v.shape[-1]
    nc = s // CHUNK

    def to_chunks(t):
        return t.reshape(b, nc, CHUNK, h, t.shape[-1]).transpose(1, 0, 3, 2, 4)

    causal = jnp.tril(jnp.ones((CHUNK, CHUNK), dtype=bool))

    def step(state, xs):
        qc, kc, gc, vc = xs
        cum = jnp.cumsum(gc, axis=2)
        diff = cum[:, :, :, None, :] - cum[:, :, None, :, :]
        decay = jnp.exp(jnp.where(causal[:, :, None], diff, -jnp.inf))
        scores = jnp.einsum('bhtk,bhsk,bhtsk->bhts', qc, kc, decay)
        o = (jnp.einsum('bhts,bhsv->bhtv', scores, vc)
             + jnp.einsum('bhtk,bhkv->bhtv', qc * jnp.exp(cum), state))
        last = cum[:, :, -1, :]
        state = (state * jnp.exp(last)[..., None]
                 + jnp.einsum('bhsk,bhsv->bhkv', kc * jnp.exp(last[:, :, None, :] - cum), vc))
        return state, o

    init = jnp.zeros((b, h, dk, dv), jnp.float32)
    _, out = lax.scan(step, init, (to_chunks(q), to_chunks(k), to_chunks(log_f), to_chunks(v)))
    return out.transpose(1, 0, 3, 2, 4).reshape(b, s, h, dv)


def mixer_sublayer(x, ln1_g, w_in, w_branch_sb, w_branch_hg, hg_norm_g, lb, w_out):
    f32 = jnp.float32
    bsz, s, _ = x.shape
    h = rmsnorm(x, ln1_g)
    proj = h @ w_in
    widths = [SB_WIDTH] * 3 + [HG_WIDTH] * 2 + [HG_VWIDTH] * 2 + [D_MODEL]
    splits = np.cumsum(widths).tolist()
    q_sb, k_sb, v_sb, q_hg, f_hg, i_hg, g_hg, gate_sb, gate_hg = jnp.split(proj, splits, axis=-1)

    def sb_heads(t):
        return t.reshape(bsz, s, SB_HEADS, SB_HEAD_DIM).transpose(0, 2, 1, 3)
    y_sb = stick_breaking_attention(sb_heads(q_sb), sb_heads(k_sb), sb_heads(v_sb))
    y_sb = y_sb.transpose(0, 2, 1, 3).reshape(bsz, s, SB_WIDTH)

    f = lb + (1.0 - lb) * jax.nn.sigmoid(f_hg.astype(f32))
    def hg_heads(t):
        return t.reshape(bsz, s, HG_HEADS, -1)
    o = hgrn2_chunk_scan(hg_heads(jax.nn.silu(q_hg.astype(f32))), hg_heads(1.0 - f),
                         hg_heads(jnp.log(f)), hg_heads(i_hg.astype(f32)))
    o = o * lax.rsqrt(jnp.mean(o * o, axis=-1, keepdims=True) + EPS)
    o = o.reshape(bsz, s, HG_VWIDTH) * hg_norm_g.astype(f32) * jax.nn.silu(g_hg.astype(f32))
    y_hg = o.astype(x.dtype)

    merged = (jax.nn.sigmoid(gate_sb) * (y_sb @ w_branch_sb)
              + jax.nn.sigmoid(gate_hg) * (y_hg @ w_branch_hg))
    return x + merged @ w_out


def hier_moe(h, w_rg, b_rg, w_re, b_re, w_gate, w_up, w_down):
    f32 = jnp.float32
    bsz, s, d = h.shape
    t = h.reshape(-1, d)
    n = t.shape[0]
    g_logits = (t @ w_rg).astype(f32) + b_rg.astype(f32)
    p_group = jax.nn.softmax(g_logits, axis=-1)
    g_idx = jnp.argmax(g_logits, axis=-1)
    w_grp = jnp.take_along_axis(p_group, g_idx[:, None], axis=1)
    e_logits = ((t @ w_re).astype(f32) + b_re.astype(f32)).reshape(n, N_GROUPS, EXPERTS_PER_GROUP)
    in_group = jnp.take_along_axis(e_logits, g_idx[:, None, None], axis=1)[:, 0]
    top_v, top_i = lax.top_k(in_group, TOP_K_INNER)
    w_sel = jax.nn.softmax(top_v, axis=-1) * w_grp
    expert_ids = g_idx[:, None] * EXPERTS_PER_GROUP + top_i
    combine = jnp.sum(jax.nn.one_hot(expert_ids, N_EXPERTS, dtype=f32) * w_sel[..., None], axis=1)
    y = jnp.zeros((n, d), f32)
    for e in range(N_EXPERTS):
        a = jax.nn.silu(t @ w_gate[e]) * (t @ w_up[e])
        y = y + combine[:, e:e + 1] * (a @ w_down[e]).astype(f32)
    return y.astype(h.dtype).reshape(bsz, s, d)


def setup_inputs(seed: int = 0) -> dict:
    key = jax.random.key(seed)
    ks = jax.random.split(key, 17)
    f32 = jnp.float32

    def nrm(k, shape, scale):
        return jax.random.normal(k, shape, f32) * scale

    return {
        'x': nrm(ks[0], (BATCH, SEQ, D_MODEL), 1.0),
        'ln1_g': 1.0 + nrm(ks[1], (DEPTH, D_MODEL), 0.02),
        'w_in': nrm(ks[2], (DEPTH, D_MODEL, IN_COLS), D_MODEL ** -0.5),
        'w_branch_sb': nrm(ks[3], (DEPTH, SB_WIDTH, D_MODEL), SB_WIDTH ** -0.5),
        'w_branch_hg': nrm(ks[4], (DEPTH, HG_VWIDTH, D_MODEL), HG_VWIDTH ** -0.5),
        'hg_norm_g': 1.0 + nrm(ks[5], (DEPTH, HG_VWIDTH), 0.02),
        'hg_lb_logits': nrm(ks[6], (DEPTH + 1, HG_WIDTH), 0.1),
        'w_out': nrm(ks[7], (DEPTH, D_MODEL, D_MODEL), D_MODEL ** -0.5),
        'ln2_g': 1.0 + nrm(ks[8], (DEPTH, D_MODEL), 0.02),
        'w_router_group': nrm(ks[9], (DEPTH, D_MODEL, N_GROUPS), D_MODEL ** -0.5),
        'b_router_group': nrm(ks[10], (DEPTH, N_GROUPS), 0.01),
        'w_router_expert': nrm(ks[11], (DEPTH, D_MODEL, N_EXPERTS), D_MODEL ** -0.5),
        'b_router_expert': nrm(ks[12], (DEPTH, N_EXPERTS), 0.01),
        'w_exp_gate': nrm(ks[13], (DEPTH, N_EXPERTS, D_MODEL, D_EXPERT), D_MODEL ** -0.5),
        'w_exp_up': nrm(ks[14], (DEPTH, N_EXPERTS, D_MODEL, D_EXPERT), D_MODEL ** -0.5),
        'w_exp_down': nrm(ks[15], (DEPTH, N_EXPERTS, D_EXPERT, D_MODEL), D_EXPERT ** -0.5),
        'final_g': 1.0 + nrm(ks[16], (D_MODEL,), 0.02),
    }


def reference(x, ln1_g, w_in, w_branch_sb, w_branch_hg, hg_norm_g, hg_lb_logits, w_out, ln2_g,
              w_router_group, b_router_group, w_router_expert, b_router_expert,
              w_exp_gate, w_exp_up, w_exp_down, final_g):
    lb_all = jnp.cumsum(jax.nn.softmax(hg_lb_logits.astype(jnp.float32), axis=0), axis=0)
    for l in range(DEPTH):
        x = mixer_sublayer(x, ln1_g[l], w_in[l], w_branch_sb[l], w_branch_hg[l], hg_norm_g[l],
                           lb_all[l], w_out[l])
        x = x + hier_moe(rmsnorm(x, ln2_g[l]), w_router_group[l], b_router_group[l],
                         w_router_expert[l], b_router_expert[l],
                         w_exp_gate[l], w_exp_up[l], w_exp_down[l])
    return rmsnorm(x, final_g)
```

```cpp
#include <hip/hip_runtime.h>
#include <cstdio>
#include <cstdint>

#ifndef MK_N_LAUNCHES
#define MK_N_LAUNCHES 1
#endif

namespace pg8 {
#define PG8_LAS __attribute__((address_space(3)))
typedef unsigned short bf16_t;
typedef short bf16x8 __attribute__((ext_vector_type(8)));
typedef float f32x4 __attribute__((ext_vector_type(4)));
typedef unsigned u32x4 __attribute__((ext_vector_type(4)));
constexpr int BM = 256, BK = 64, HALF = 128, HTB = HALF * BK * 2  , STAGE_BYTES = 8 * HTB, NXCD = 8, WGM = 8;

__host__ __device__ __forceinline__ int lds_byte(int r, int c) { const int st = (r >> 4) * 2 + (c >> 5), rr = r & 15, cc = c & 31, ob = rr * 64 + cc * 2; return st * 1024 + (ob ^ (((ob >> 9) & 1) << 5)); }
__host__ __device__ __forceinline__ void stage_rc(int b, int& R, int& C) { const int st = b / 1024, sb = b % 1024, swz = sb ^ (((sb >> 9) & 1) << 5); R = (st >> 1) * 16 + swz / 64; C = (st & 1) * 32 + (swz % 64) / 2; }
__host__ __device__ __forceinline__ int perm32(int rho) { const int n = rho >> 4, i = rho & 15; return 8 * (i >> 2) + 4 * n + (i & 3); }

struct Unit { int pm, pn; };
struct Gemm { const bf16_t* A; const bf16_t* Bt; int M, N, K; };

__host__ __device__ __forceinline__ int xcd_remap(int wgid, int nwg) { const int q = nwg / NXCD, r = nwg % NXCD, xcd = wgid % NXCD, off = wgid / NXCD; return (xcd < r ? xcd * (q + 1) : r * (q + 1) + (xcd - r) * q) + off; }

struct StaticOrder {
    int nM, nN, nwg, G, c;
    __host__ __device__ void init(int M, int N, int G_, int c_) { nM = M / BM; nN = N / BM; nwg = nM * nN; G = G_; c = c_; }
    __host__ __device__ bool next(int i, Unit& u) const {
        const long L = (long)i * G + c; if (L >= nwg) return false;
        const int wgid = xcd_remap((int)L, nwg);
        const int nig = WGM * nN, gid = wgid / nig, fm = gid * WGM, gsz = (nM - fm) < WGM ? (nM - fm) : WGM;
        u.pm = fm + ((wgid % nig) % gsz); u.pn = (wgid % nig) / gsz; return true;
    }
};
struct BranchOrder {
    StaticOrder S;
    __device__ bool next(int i, Unit& u) const { if (i >= 2) return false; if (!S.next(0, u)) return false; if (i == 1) { u.pm += 64; u.pn += 4; } return true; }
};
struct MoeOrder {
    int nwg, G, c; const PG8_LAS int* tp;
    __device__ bool next(int i, Unit& u) const {
        const long L = (long)i * G + c; if (L >= nwg) return false;
        const int wgid = xcd_remap((int)L, nwg); const int mt = wgid >> 2, nt = wgid & 3; int e = 0;
#pragma unroll
        for (int j = 1; j < 16; ++j) e += (mt >= tp[j]) ? 1 : 0;
        u.pm = mt; u.pn = e * 4 + nt; return true;
    }
};

__device__ __forceinline__ unsigned cvt_pk_bf16(float lo, float hi) { typedef float f2_ __attribute__((ext_vector_type(2))); typedef __bf16 b2_ __attribute__((ext_vector_type(2))); f2_ v = {lo, hi}; return __builtin_bit_cast(unsigned, __builtin_convertvector(v, b2_)); }
__device__ __forceinline__ float bf_lo(unsigned u) { return __uint_as_float(u << 16); }
__device__ __forceinline__ float bf_hi(unsigned u) { return __uint_as_float(u & 0xffff0000u); }
template <int CTRL> __device__ __forceinline__ float dpp_f(float v) { return __builtin_bit_cast(float, __builtin_amdgcn_update_dpp(0, __builtin_bit_cast(int, v), CTRL, 0xF, 0xF, true)); }
__device__ __forceinline__ float sigmoidf_(float x) { return __builtin_amdgcn_rcpf(1.0f + __expf(-x)); }


struct EpiProj {
    static constexpr bool PERM = true, AFTER_DRAIN = false;
    bf16_t *Qs, *Ks, *Vs, *Qh, *Kh, *Vh, *Gh, *gsb, *ghg; float* logf; float *emid, *elm, *dec; const float* lbl;
    __device__ __forceinline__ bool keep(const Unit&) const { return false; }
    __device__ __forceinline__ void operator()(f32x4 (&acc)[2][2][4][2], const Unit& u, int wr, int wc, int fr, int fq) const {
        const int colt = u.pn * BM, grp = colt >> 9;
        const int row0 = u.pm * BM + wr * 64 + fr;
        int act = 0, pitch = 512, cb = (colt & 511) + wc * 32 + 8 * fq; bf16_t* dst = Qs;
        if (grp == 1) dst = Ks; else if (grp == 2) dst = Vs; else if (grp == 3) { dst = Qh; act = 1; } else if (grp == 4) { dst = Kh; act = 3; } else if (grp == 5) dst = Vh;
        else if (grp == 6) { dst = Gh; act = 1; } else if (grp == 7 || grp == 8) { dst = gsb; act = 2; pitch = 1024; cb = (colt - 3584) + wc * 32 + 8 * fq; }
        else if (grp >= 9) { dst = ghg; act = 2; pitch = 1024; cb = (colt - 4608) + wc * 32 + 8 * fq; }
        if (act == 2) {
            const int gc = ((colt - 3584) >> 8) * 128 + wc * 32 + 8 * fq;
#pragma unroll
            for (int ai = 0; ai < 2; ++ai)
#pragma unroll
                for (int m = 0; m < 4; ++m) { const size_t off = (size_t)(row0 + ai * HALF + m * 16) * 1024 + gc; float rr[8], ss[8];
#pragma unroll
                    for (int j = 0; j < 8; ++j) { const float a = sigmoidf_(acc[ai][0][m][j >> 2][j & 3]), b = fmaxf(sigmoidf_(acc[ai][1][m][j >> 2][j & 3]), 1e-30f); ss[j] = b; rr[j] = a * __builtin_amdgcn_rcpf(b); }
                    u32x4 w; w.x = cvt_pk_bf16(rr[0], rr[1]); w.y = cvt_pk_bf16(rr[2], rr[3]); w.z = cvt_pk_bf16(rr[4], rr[5]); w.w = cvt_pk_bf16(rr[6], rr[7]);
                    *(u32x4*)(gsb + off) = w;
                    u32x4 w2; w2.x = cvt_pk_bf16(ss[0], ss[1]); w2.y = cvt_pk_bf16(ss[2], ss[3]); w2.z = cvt_pk_bf16(ss[4], ss[5]); w2.w = cvt_pk_bf16(ss[6], ss[7]);
                    *(u32x4*)(ghg + off) = w2; }
            return;
        }
        float lb[2][8];
        if (act == 3) {
#pragma unroll
            for (int bj = 0; bj < 2; ++bj)
#pragma unroll
                for (int j = 0; j < 8; ++j) { const int c = cb + bj * HALF + j; lb[bj][j] = __builtin_amdgcn_rcpf(1.0f + __expf(lbl[512 + c] - lbl[c])); }
        }
#pragma unroll
        for (int ai = 0; ai < 2; ++ai)
#pragma unroll
            for (int m = 0; m < 4; ++m) { const size_t row = (size_t)(row0 + ai * HALF + m * 16);
#pragma unroll
                for (int bj = 0; bj < 2; ++bj) {
                    float v[8]; { const f32x4 a = acc[ai][bj][m][0], b = acc[ai][bj][m][1]; v[0] = a[0]; v[1] = a[1]; v[2] = a[2]; v[3] = a[3]; v[4] = b[0]; v[5] = b[1]; v[6] = b[2]; v[7] = b[3]; }
                    if (act == 1) {
#pragma unroll
                        for (int j = 0; j < 8; ++j) v[j] = v[j] * sigmoidf_(v[j]);
                    } else if (act == 3) {
#pragma unroll
                        for (int j = 0; j < 8; ++j) { const float l = lb[bj][j], sg = sigmoidf_(v[j]); const float f = l + (1.0f - l) * sg; const float lg = __logf(f); v[j] = 1.0f - f;
                            acc[ai][bj][m][j >> 2][j & 3] = lg; }
                    }
                    u32x4 w; w.x = cvt_pk_bf16(v[0], v[1]); w.y = cvt_pk_bf16(v[2], v[3]); w.z = cvt_pk_bf16(v[4], v[5]); w.w = cvt_pk_bf16(v[6], v[7]);
                    *(u32x4*)(dst + row * pitch + cb + bj * HALF) = w;
                } }
        if (act == 3) {
#pragma unroll
            for (int ai = 0; ai < 2; ++ai)
#pragma unroll
                for (int bj = 0; bj < 2; ++bj) { float mid[8], last[8];
#pragma unroll
                    for (int j = 0; j < 8; ++j) { float carry = 0.f;
#pragma unroll
                        for (int m = 0; m < 4; ++m) { float x = acc[ai][bj][m][j >> 2][j & 3];
                            x += dpp_f<0x111>(x); x += dpp_f<0x112>(x); x += dpp_f<0x114>(x); x += dpp_f<0x118>(x);
                            x += carry; acc[ai][bj][m][j >> 2][j & 3] = x; carry = dpp_f<0x15F>(x); if (m == 1) mid[j] = carry; }
                        last[j] = carry; }
#pragma unroll
                    for (int m = 0; m < 4; ++m) { bf16_t* kq = Kh + (size_t)(row0 + ai * HALF + m * 16) * 512 + cb + bj * HALF;
                        const u32x4 kw = *(const u32x4*)kq; float bb[8] = {bf_lo(kw.x), bf_hi(kw.x), bf_lo(kw.y), bf_hi(kw.y), bf_lo(kw.z), bf_hi(kw.z), bf_lo(kw.w), bf_hi(kw.w)};
#pragma unroll
                        for (int j = 0; j < 8; ++j) bb[j] *= __expf(mid[j] - acc[ai][bj][m][j >> 2][j & 3]);
                        u32x4 w; w.x = cvt_pk_bf16(bb[0], bb[1]); w.y = cvt_pk_bf16(bb[2], bb[3]); w.z = cvt_pk_bf16(bb[4], bb[5]); w.w = cvt_pk_bf16(bb[6], bb[7]);
                        *(u32x4*)kq = w;
                        float ea[8];
#pragma unroll
                        for (int j = 0; j < 8; ++j) ea[j] = __expf(acc[ai][bj][m][j >> 2][j & 3] - mid[j]);
                        u32x4 w2; w2.x = cvt_pk_bf16(ea[0], ea[1]); w2.y = cvt_pk_bf16(ea[2], ea[3]); w2.z = cvt_pk_bf16(ea[4], ea[5]); w2.w = cvt_pk_bf16(ea[6], ea[7]);
                        *(u32x4*)((bf16_t*)logf + (size_t)(row0 + ai * HALF + m * 16) * 512 + cb + bj * HALF) = w2; }
                    if (fr == 15) { const size_t vo = (size_t)(4 * u.pm + 2 * ai + wr) * 512 + cb + bj * HALF;
                        *(f32x4*)(emid + vo) = (f32x4){__expf(mid[0]), __expf(mid[1]), __expf(mid[2]), __expf(mid[3])}; *(f32x4*)(emid + vo + 4) = (f32x4){__expf(mid[4]), __expf(mid[5]), __expf(mid[6]), __expf(mid[7])};
                        *(f32x4*)(elm + vo) = (f32x4){__expf(last[0] - mid[0]), __expf(last[1] - mid[1]), __expf(last[2] - mid[2]), __expf(last[3] - mid[3])};
                        *(f32x4*)(elm + vo + 4) = (f32x4){__expf(last[4] - mid[4]), __expf(last[5] - mid[5]), __expf(last[6] - mid[6]), __expf(last[7] - mid[7])};
                        *(f32x4*)(dec + vo) = (f32x4){__expf(last[0]), __expf(last[1]), __expf(last[2]), __expf(last[3])}; *(f32x4*)(dec + vo + 4) = (f32x4){__expf(last[4]), __expf(last[5]), __expf(last[6]), __expf(last[7])}; } }
        }
    }
};

struct EpiBranch {
    static constexpr bool PERM = true, AFTER_DRAIN = false;
    const bf16_t *gsb, *ghg; bf16_t* out;
    __device__ __forceinline__ bool keep(const Unit& u) const { return u.pn < 4; }
    __device__ __forceinline__ void operator()(f32x4 (&acc)[2][2][4][2], const Unit& u, int wr, int wc, int fr, int fq) const {
        const bool first = u.pn < 4; const int pn = u.pn & 3, pm = u.pm & 63;
        const int row0 = pm * BM + wr * 64 + fr, col0 = pn * BM + wc * 32 + 8 * fq;
        const bf16_t* gp = first ? gsb : ghg;
#pragma unroll
        for (int ai = 0; ai < 2; ++ai)
#pragma unroll
            for (int m = 0; m < 4; ++m) { const size_t off = (size_t)(row0 + ai * HALF + m * 16) * 1024 + col0;
#pragma unroll
                for (int bj = 0; bj < 2; ++bj) {
                    const u32x4 gh = *(const u32x4*)(gp + off + bj * HALF);
                    const float s[8] = {bf_lo(gh.x), bf_hi(gh.x), bf_lo(gh.y), bf_hi(gh.y), bf_lo(gh.z), bf_hi(gh.z), bf_lo(gh.w), bf_hi(gh.w)};
                    f32x4 a = acc[ai][bj][m][0], b = acc[ai][bj][m][1];
                    a[0] *= s[0]; a[1] *= s[1]; a[2] *= s[2]; a[3] *= s[3]; b[0] *= s[4]; b[1] *= s[5]; b[2] *= s[6]; b[3] *= s[7];
                    acc[ai][bj][m][0] = a; acc[ai][bj][m][1] = b;
                    if (!first) { u32x4 w; w.x = cvt_pk_bf16(a[0], a[1]); w.y = cvt_pk_bf16(a[2], a[3]); w.z = cvt_pk_bf16(b[0], b[1]); w.w = cvt_pk_bf16(b[2], b[3]);
                        *(u32x4*)(out + off + bj * HALF) = w; }
                } }
    }
};

struct EpiResBf16 {
    static constexpr bool PERM = true, AFTER_DRAIN = false;
    const float* base; bf16_t* out;
    __device__ __forceinline__ bool keep(const Unit&) const { return false; }
    __device__ __forceinline__ void operator()(f32x4 (&acc)[2][2][4][2], const Unit& u, int wr, int wc, int fr, int fq) const {
        const int row0 = u.pm * BM + wr * 64 + fr, col0 = u.pn * BM + wc * 32 + 8 * fq;
#pragma unroll
        for (int ai = 0; ai < 2; ++ai)
#pragma unroll
            for (int m = 0; m < 4; ++m) { const size_t off = (size_t)(row0 + ai * HALF + m * 16) * 1024 + col0;
#pragma unroll
                for (int bj = 0; bj < 2; ++bj) { const f32x4 x0 = *(const f32x4*)(base + off + bj * HALF) + acc[ai][bj][m][0], x1 = *(const f32x4*)(base + off + bj * HALF + 4) + acc[ai][bj][m][1];
                    u32x4 w; w.x = cvt_pk_bf16(x0[0], x0[1]); w.y = cvt_pk_bf16(x0[2], x0[3]); w.z = cvt_pk_bf16(x1[0], x1[1]); w.w = cvt_pk_bf16(x1[2], x1[3]);
                    *(u32x4*)(out + off + bj * HALF) = w; } }
    }
};

struct EpiMoeUp {
    static constexpr bool PERM = true, AFTER_DRAIN = false;
    bf16_t* H;
    __device__ __forceinline__ bool keep(const Unit&) const { return false; }
    __device__ __forceinline__ void operator()(f32x4 (&acc)[2][2][4][2], const Unit& u, int wr, int wc, int fr, int fq) const {
        const int nt = u.pn & 3; const int row0 = u.pm * BM + wr * 64 + fr, col0 = nt * 128 + wc * 32 + 8 * fq;
#pragma unroll
        for (int ai = 0; ai < 2; ++ai)
#pragma unroll
            for (int m = 0; m < 4; ++m) { const size_t off = (size_t)(row0 + ai * HALF + m * 16) * 512 + col0;
                float v[8];
#pragma unroll
                for (int n = 0; n < 2; ++n)
#pragma unroll
                    for (int j = 0; j < 4; ++j) { const float g = acc[ai][0][m][n][j], up = acc[ai][1][m][n][j]; v[n * 4 + j] = g * sigmoidf_(g) * up; }
                u32x4 w; w.x = cvt_pk_bf16(v[0], v[1]); w.y = cvt_pk_bf16(v[2], v[3]); w.z = cvt_pk_bf16(v[4], v[5]); w.w = cvt_pk_bf16(v[6], v[7]);
                *(u32x4*)(H + off) = w; }
    }
};

struct EpiMoeDown {
    static constexpr bool PERM = true, AFTER_DRAIN = false;
    const int* rowtok; const float* roww; bf16_t* Y0; bf16_t* Y1;
    __device__ __forceinline__ bool keep(const Unit&) const { return false; }
    __device__ __forceinline__ void operator()(f32x4 (&acc)[2][2][4][2], const Unit& u, int wr, int wc, int fr, int fq) const {
        const int nt = u.pn & 3; const int row0 = u.pm * BM + wr * 64 + fr, col0 = nt * BM + wc * 32 + 8 * fq;
#pragma unroll
        for (int ai = 0; ai < 2; ++ai)
#pragma unroll
            for (int m = 0; m < 4; ++m) { const int prow = row0 + ai * HALF + m * 16; const int ts = rowtok[prow]; const float w = roww[prow];
                if (ts >= 0) { bf16_t* yp = ((ts & 1) ? Y1 : Y0) + (size_t)(ts >> 1) * 1024 + col0;
#pragma unroll
                    for (int bj = 0; bj < 2; ++bj) { const f32x4 a = acc[ai][bj][m][0] * w, b = acc[ai][bj][m][1] * w;
                        u32x4 o; o.x = cvt_pk_bf16(a[0], a[1]); o.y = cvt_pk_bf16(a[2], a[3]); o.z = cvt_pk_bf16(b[0], b[1]); o.w = cvt_pk_bf16(b[2], b[3]);
                        *(u32x4*)(yp + bj * HALF) = o; } } }
    }
};

template <class Epi, class Sched, bool ALIGN_EPI = false, bool SP2 = false, bool GATHER = false>
__device__ __forceinline__ void gemm_phase(PG8_LAS unsigned char* lds, const Gemm g, const Sched& S, const Epi& E, const int* rowidx = nullptr) {
    static_assert(!GATHER || SP2, "GATHER is implemented for the SP2 loop");
    int tid_ = threadIdx.x; asm volatile("" : "+v"(tid_));
    const int tid = tid_, wid = __builtin_amdgcn_readfirstlane(tid >> 6), lane = tid & 63, wr = wid >> 2, wc = wid & 3, fr = lane & 15, fq = lane >> 4;
    const int K = g.K, nt = K / BK;
    unsigned voffA[2], voffB[2]; int rslot[2] = {0, 0}; unsigned coff[2] = {0u, 0u};
#pragma unroll
    for (int i = 0; i < 2; ++i) { int R, C; stage_rc(tid * 16 + i * 8192, R, C); const int Rb = Epi::PERM ? ((R & ~31) + perm32(R & 31)) : R;
        voffA[i] = (unsigned)(R * K + C) * 2u; voffB[i] = (unsigned)(Rb * K + C) * 2u; if constexpr (GATHER) { rslot[i] = R; coff[i] = (unsigned)C * 2u; } }
    const size_t kstep = (size_t)(BK * 2);
    const size_t hstep = (size_t)HALF * K * 2;
    const size_t tstep = 2 * hstep;
    const unsigned ldsw = (unsigned)wid * 1024u;
    const int aoff = lds_byte(wr * 64 + fr, fq * 8), boff = lds_byte(wc * 32 + fr, fq * 8);
#define PG8_SA(b, h) (((b) * 2 + (h)) * HTB)
#define PG8_SB(b, h) ((4 + (b) * 2 + (h)) * HTB)
#define PG8_STAGE(bufoff, gbase, voff) do { _Pragma("unroll") for (int _i = 0; _i < 2; ++_i) \
        __builtin_amdgcn_global_load_lds((const unsigned*)((const char*)(gbase) + (voff)[_i]), (PG8_LAS unsigned*)(lds + (bufoff) + ldsw + _i * 8192), 16, 0, 0); } while (0)
#define PG8_LDA(dst, b, h) do { _Pragma("unroll") for (int m = 0; m < 4; ++m) _Pragma("unroll") for (int k = 0; k < 2; ++k) dst[m][k] = *(const PG8_LAS bf16x8*)(lds + PG8_SA(b, h) + aoff + m * 2048 + k * 1024); } while (0)
#define PG8_LDB(dst, b, h) do { _Pragma("unroll") for (int n = 0; n < 2; ++n) _Pragma("unroll") for (int k = 0; k < 2; ++k) dst[n][k] = *(const PG8_LAS bf16x8*)(lds + PG8_SB(b, h) + boff + n * 2048 + k * 1024); } while (0)
#define PG8_MMA(ai, bj, At, Bt) do { __builtin_amdgcn_s_setprio(1); _Pragma("unroll") for (int m = 0; m < 4; ++m) _Pragma("unroll") for (int n = 0; n < 2; ++n) _Pragma("unroll") for (int k = 0; k < 2; ++k) \
        acc[ai][bj][m][n] = __builtin_amdgcn_mfma_f32_16x16x32_bf16(Bt[n][k], At[m][k], acc[ai][bj][m][n], 0, 0, 0); __builtin_amdgcn_s_setprio(0); } while (0)
#define PG8_WAIT_V(n) asm volatile("s_waitcnt vmcnt(" #n ")" ::: "memory")
#define PG8_WAIT_L(n) asm volatile("s_waitcnt lgkmcnt(" #n ")" ::: "memory")
#define PG8_BAR __builtin_amdgcn_s_barrier()
#define PG8_SCHED __builtin_amdgcn_sched_barrier(0)
    Unit cur, nxt; int ui = 0;
    if (!S.next(0, cur)) return;
    f32x4 acc[2][2][4][2];
#pragma unroll
    for (int a = 0; a < 2; ++a)
#pragma unroll
        for (int b = 0; b < 2; ++b)
#pragma unroll
            for (int m = 0; m < 4; ++m)
#pragma unroll
                for (int n = 0; n < 2; ++n) acc[a][b][m][n] = (f32x4){0.f, 0.f, 0.f, 0.f};
    bf16x8 At[4][2], B0[2][2], B1[2][2];
    unsigned gC[2][2], gN[2][2];
#define PG8_ROWOFFS(dst, U) do { _Pragma("unroll") for (int h_ = 0; h_ < 2; ++h_) _Pragma("unroll") for (int i_ = 0; i_ < 2; ++i_) { \
        if constexpr (GATHER) { const int t_ = rowidx[(U).pm * BM + h_ * HALF + rslot[i_]]; dst[h_][i_] = (unsigned)((t_ < 0 ? 0 : (t_ >> 1)) * K) * 2u + coff[i_]; } \
        else dst[h_][i_] = voffA[i_] + (unsigned)(h_ * hstep); } } while (0)
    PG8_ROWOFFS(gC, cur);
#pragma unroll
    for (int h_ = 0; h_ < 2; ++h_)
#pragma unroll
        for (int i_ = 0; i_ < 2; ++i_) gN[h_][i_] = gC[h_][i_];
    const char* cA = (const char*)g.A + (GATHER ? (size_t)0 : (size_t)cur.pm * tstep); const char* cB = (const char*)g.Bt + (size_t)cur.pn * tstep;
    if constexpr (SP2) {
        PG8_STAGE(PG8_SB(0, 0), cB, voffB); PG8_STAGE(PG8_SB(0, 1), cB + hstep, voffB); PG8_STAGE(PG8_SA(0, 0), cA, gC[0]); PG8_STAGE(PG8_SA(0, 1), cA, gC[1]);
        if (wr == 1) PG8_BAR;
        PG8_WAIT_V(2); PG8_BAR;
        PG8_STAGE(PG8_SB(1, 0), cB + kstep, voffB); PG8_STAGE(PG8_SA(1, 0), cA + kstep, gC[0]); PG8_STAGE(PG8_SB(1, 1), cB + hstep + kstep, voffB);
        PG8_WAIT_V(6); PG8_BAR;
    } else {
        PG8_STAGE(PG8_SB(0, 0), cB, voffB); PG8_STAGE(PG8_SA(0, 0), cA, voffA); PG8_STAGE(PG8_SB(0, 1), cB + hstep, voffB); PG8_STAGE(PG8_SA(0, 1), cA + hstep, voffA);
        if (wr == 1) PG8_BAR;
        PG8_WAIT_V(4); PG8_BAR;
        PG8_STAGE(PG8_SB(1, 0), cB + kstep, voffB); PG8_STAGE(PG8_SA(1, 0), cA + kstep, voffA); PG8_STAGE(PG8_SB(1, 1), cB + hstep + kstep, voffB);
        PG8_WAIT_V(6); PG8_BAR;
    }
    for (;;) {
        const bool has_next = S.next(ui + 1, nxt);
        const char* nA = (has_next && !GATHER) ? (const char*)g.A + (size_t)nxt.pm * tstep : cA; const char* nB = has_next ? (const char*)g.Bt + (size_t)nxt.pn * tstep : cB;
        if (has_next) { PG8_ROWOFFS(gN, nxt); }
        for (int t = 0; t < nt; t += 2) {
            const bool last = (t == nt - 2);
            const char* a1 = cA + (size_t)(t + 1) * kstep;
            const char* a2 = last ? nA : cA + (size_t)(t + 2) * kstep; const char* b2 = last ? nB : cB + (size_t)(t + 2) * kstep;
            const char* a3 = a2 + kstep; const char* b3 = b2 + kstep;
            if constexpr (SP2) {
            unsigned g2[2][2];
#pragma unroll
            for (int h_ = 0; h_ < 2; ++h_)
#pragma unroll
                for (int i_ = 0; i_ < 2; ++i_) g2[h_][i_] = last ? gN[h_][i_] : gC[h_][i_];
            PG8_LDB(B0, 0, 0); PG8_LDB(B1, 0, 1); PG8_SCHED; PG8_LDA(At, 0, 0); PG8_STAGE(PG8_SA(1, 1), a1, gC[1]);
            PG8_WAIT_V(8); PG8_WAIT_L(0); PG8_BAR; PG8_MMA(0, 0, At, B0); PG8_MMA(0, 1, At, B1); PG8_BAR; PG8_SCHED;
            PG8_LDA(At, 0, 1); PG8_STAGE(PG8_SB(0, 0), b2, voffB); PG8_STAGE(PG8_SB(0, 1), b2 + hstep, voffB); PG8_STAGE(PG8_SA(0, 0), a2, g2[0]);
            PG8_WAIT_V(8); PG8_WAIT_L(0); PG8_BAR; PG8_MMA(1, 0, At, B0); PG8_MMA(1, 1, At, B1); PG8_BAR; PG8_SCHED;
            PG8_LDB(B0, 1, 0); PG8_LDB(B1, 1, 1); PG8_SCHED; PG8_LDA(At, 1, 0); PG8_STAGE(PG8_SA(0, 1), a2, g2[1]);
            PG8_WAIT_V(8); PG8_WAIT_L(0); PG8_BAR; PG8_MMA(0, 0, At, B0); PG8_MMA(0, 1, At, B1); PG8_BAR; PG8_SCHED;
            PG8_LDA(At, 1, 1); PG8_STAGE(PG8_SB(1, 0), b3, voffB); PG8_STAGE(PG8_SB(1, 1), b3 + hstep, voffB); PG8_STAGE(PG8_SA(1, 0), a3, g2[0]);
            PG8_WAIT_V(8); PG8_WAIT_L(0); PG8_BAR; PG8_MMA(1, 0, At, B0); PG8_MMA(1, 1, At, B1); PG8_BAR; PG8_SCHED;
            } else {
            PG8_LDB(B0, 0, 0); PG8_SCHED; PG8_LDA(At, 0, 0); PG8_STAGE(PG8_SA(1, 1), a1 + hstep, voffA);
            PG8_WAIT_L(8); PG8_BAR; PG8_WAIT_L(0); PG8_MMA(0, 0, At, B0); PG8_BAR; PG8_SCHED;
            PG8_LDB(B1, 0, 1); PG8_STAGE(PG8_SB(0, 0), b2, voffB);
            PG8_BAR; PG8_WAIT_L(0); PG8_MMA(0, 1, At, B1); PG8_BAR;
            PG8_LDA(At, 0, 1); PG8_STAGE(PG8_SA(0, 0), a2, voffA);
            PG8_BAR; PG8_WAIT_L(0); PG8_MMA(1, 0, At, B0); PG8_BAR; PG8_SCHED;
            PG8_STAGE(PG8_SB(0, 1), b2 + hstep, voffB);
            PG8_WAIT_V(6); PG8_BAR; PG8_MMA(1, 1, At, B1); PG8_BAR;
            PG8_LDB(B0, 1, 0); PG8_SCHED; PG8_LDA(At, 1, 0); PG8_STAGE(PG8_SA(0, 1), a2 + hstep, voffA);
            PG8_WAIT_L(8); PG8_BAR; PG8_WAIT_L(0); PG8_MMA(0, 0, At, B0); PG8_BAR; PG8_SCHED;
            PG8_LDB(B1, 1, 1); PG8_STAGE(PG8_SB(1, 0), b3, voffB);
            PG8_BAR; PG8_WAIT_L(0); PG8_MMA(0, 1, At, B1); PG8_BAR;
            PG8_LDA(At, 1, 1); PG8_STAGE(PG8_SA(1, 0), a3, voffA);
            PG8_BAR; PG8_WAIT_L(0); PG8_MMA(1, 0, At, B0); PG8_BAR; PG8_SCHED;
            PG8_STAGE(PG8_SB(1, 1), b3 + hstep, voffB);
            PG8_WAIT_V(6); PG8_BAR; PG8_MMA(1, 1, At, B1); PG8_BAR;
            }
        }
        if constexpr (ALIGN_EPI) { if (wr == 0) PG8_BAR; }
        E(acc, cur, wr, wc, fr, fq);
        if (!has_next) break;
        if (!E.keep(cur)) {
#pragma unroll
        for (int a = 0; a < 2; ++a)
#pragma unroll
            for (int b = 0; b < 2; ++b)
#pragma unroll
                for (int m = 0; m < 4; ++m)
#pragma unroll
                    for (int n = 0; n < 2; ++n) acc[a][b][m][n] = (f32x4){0.f, 0.f, 0.f, 0.f};
        }
        cur = nxt; cA = nA; cB = nB; ++ui;
#pragma unroll
        for (int h_ = 0; h_ < 2; ++h_)
#pragma unroll
            for (int i_ = 0; i_ < 2; ++i_) gC[h_][i_] = gN[h_][i_];
        if constexpr (ALIGN_EPI) { if (wr == 1) PG8_BAR; }
    }
    PG8_WAIT_V(0);
    if constexpr (!ALIGN_EPI) { if (wr == 0) PG8_BAR; }
    PG8_BAR;
#undef PG8_ROWOFFS
#undef PG8_SA
#undef PG8_SB
#undef PG8_STAGE
#undef PG8_LDA
#undef PG8_LDB
#undef PG8_MMA
#undef PG8_WAIT_V
#undef PG8_WAIT_L
#undef PG8_BAR
#undef PG8_SCHED
}
}

#ifndef PG8_SP2
#define PG8_SP2 true
#endif
#ifndef PG8_ALIGN
#define PG8_ALIGN true
#endif

constexpr int NWAVES = 8;
constexpr int N_LAUNCHES = MK_N_LAUNCHES;
constexpr int N_PHASES = 12;
constexpr int BATCH = 2, SEQ = 8192, D = 1024, M = BATCH * SEQ;
constexpr int HW = 512;
constexpr int IN_COLS = 5632, NEXP = 16, DEXP = 512;
constexpr float EPS = 1e-6f;
constexpr int MOE_ROWS = 36864;
constexpr float SB_EXIT = 30.0f;

constexpr size_t MiB = 1u << 20;
constexpr size_t WS_CTL = 0, CTL_ZERO_BYTES = 1 * MiB;
constexpr size_t WS_SMALL = 1 * MiB;
constexpr size_t WS_WIN = 4 * MiB;
constexpr size_t WS_WBR = 15 * MiB;
constexpr size_t WS_WOUT = 17 * MiB;
constexpr size_t WS_W1 = 19 * MiB;
constexpr size_t WS_WD = 51 * MiB;
constexpr size_t WS_XN = 67 * MiB;
constexpr size_t WS_QS = 99 * MiB;
constexpr size_t WS_KS = 115 * MiB, WS_VS = 131 * MiB, WS_QH = 147 * MiB, WS_KH = 163 * MiB, WS_VH = 179 * MiB;
constexpr size_t WS_SIN = 83 * MiB;
constexpr size_t WS_LOGF = 195 * MiB;
constexpr size_t WS_GH = 227 * MiB;
constexpr size_t WS_TS = 99 * MiB;
constexpr size_t WS_X1 = 131 * MiB;
constexpr size_t WS_H = 171 * MiB;
constexpr size_t WS_Y1 = 207 * MiB;
constexpr size_t WS_END = 256 * MiB;
static_assert(WS_GH + (size_t)M * HW * 2 <= WS_END && WS_Y1 + (size_t)M * D * 2 <= WS_END && WS_TS + (size_t)M * D * 2 <= WS_X1 && WS_X1 + (size_t)M * D * 2 <= WS_H && WS_H + (size_t)MOE_ROWS * DEXP * 2 <= WS_Y1, "ws map");
constexpr size_t SM_HIST = 0;
constexpr size_t SM_META = 16384;
constexpr size_t SM_TOKE = 32768;
constexpr size_t SM_TOKW = SM_TOKE + (size_t)M * 8;
constexpr size_t SM_RSTD = SM_TOKW + (size_t)M * 8;
constexpr size_t SM_ROWTOK = SM_RSTD + (size_t)M * 4;
constexpr size_t SM_ROWW = SM_ROWTOK + (size_t)MOE_ROWS * 4;
constexpr size_t SM_DEC = SM_ROWW + (size_t)MOE_ROWS * 4;
constexpr size_t SM_EMID = SM_DEC + 256 * 512 * 4, SM_ELM = SM_EMID + 256 * 512 * 4;
static_assert(WS_SMALL + SM_ELM + 256 * 512 * 4 <= WS_WIN, "small arrays");
constexpr int CW_BAR = 4096;

constexpr int RING_BYTES = 131072;
constexpr int LDSCTL_OFF = 143360, MISC_OFF = LDSCTL_OFF + 320;
constexpr int LDS_BYTES = 147456;

#define GAS __attribute__((address_space(1)))
#define LAS __attribute__((address_space(3)))
typedef unsigned short bf16;
typedef unsigned v4u __attribute__((ext_vector_type(4)));
typedef unsigned v2u __attribute__((ext_vector_type(2)));
typedef float f32x4 __attribute__((ext_vector_type(4)));
typedef GAS unsigned gu32;
#define RLX_AGENT __ATOMIC_RELAXED, __HIP_MEMORY_SCOPE_AGENT
#define LDS_WAIT() asm volatile("s_waitcnt lgkmcnt(0)" ::: "memory")
#define VM_WAIT() asm volatile("s_waitcnt vmcnt(0)" ::: "memory")
__device__ __forceinline__ unsigned f2bf(float f) { unsigned u = __builtin_bit_cast(unsigned, f); return (u + 0x7fffu + ((u >> 16) & 1u)) >> 16; }
__device__ __forceinline__ unsigned pk2(float lo, float hi) { return f2bf(lo) | (f2bf(hi) << 16); }
__device__ __forceinline__ float bf2f(bf16 v) { return __uint_as_float((unsigned)v << 16); }
__device__ __forceinline__ float blo(unsigned u) { return __uint_as_float(u << 16); }
__device__ __forceinline__ float bhi(unsigned u) { return __uint_as_float(u & 0xffff0000u); }

#define XB_TMO      128
#define XB_XCNT(j)  (256  + 64 * (j))
#define XB_XSUB(j)  (1280 + 64 * (j))
#define XB_XGEN(j)  (2304 + 64 * (j))
#define XB_TOP      3328
#define XB_TOPGEN   3392
#define XCD_BAR_WORDS 3456
#define XB_SPIN_CAP (1u << 18)
__device__ __forceinline__ unsigned xb_ld(unsigned* p)              { return __hip_atomic_load(p, __ATOMIC_RELAXED, __HIP_MEMORY_SCOPE_AGENT); }
__device__ __forceinline__ unsigned xb_add(unsigned* p, unsigned v) { return __hip_atomic_fetch_add(p, v, __ATOMIC_RELAXED, __HIP_MEMORY_SCOPE_AGENT); }
__device__ __forceinline__ unsigned xb_xcc_id() { return (unsigned)__builtin_amdgcn_s_getreg((3 << 11) | 20) & 0xFu; }
#define XB_SPIN(cond, bar) do { unsigned _sp = 0; while (cond) { __builtin_amdgcn_s_sleep(1); \
    if ((++_sp & 255u) == 0u) { if (xb_ld(&(bar)[XB_TMO])) break; if (_sp > XB_SPIN_CAP) { atomicAdd(&(bar)[XB_TMO], 1u); break; } } } } while (0)
struct XcdBarrier { unsigned* bar; unsigned x; volatile LAS unsigned* st; };
__device__ __forceinline__ XcdBarrier xcd_barrier_post(unsigned* bar, volatile LAS unsigned* st) {
    XcdBarrier b; b.bar = bar; b.x = xb_xcc_id(); b.st = st;
    if (threadIdx.x == 0) (void)xb_add(&bar[XB_XCNT(b.x)], 1u);
    return b;
}
__device__ __forceinline__ void xcd_barrier_complete(unsigned* bar, unsigned x, unsigned& nloc, unsigned& nx) {
    const unsigned G = gridDim.x * gridDim.y * gridDim.z;
    unsigned sum, cnt, mine, sp = 0u;
    for (;;) {
        sum = 0u; cnt = 0u; mine = 0u;
#pragma unroll
        for (unsigned j = 0; j < 16; ++j) { const unsigned c = xb_ld(&bar[XB_XCNT(j)]); sum += c; cnt += (c > 0u) ? 1u : 0u; mine = (j == x) ? c : mine; }
        if (sum == G) break;
        __builtin_amdgcn_s_sleep(1);
        if ((++sp & 255u) == 0u) { if (xb_ld(&bar[XB_TMO])) break; if (sp > XB_SPIN_CAP) { atomicAdd(&bar[XB_TMO], 1u); break; } }
    }
    nloc = mine > 0u ? mine : 1u; nx = cnt > 0u ? cnt : 1u;
}
__device__ __forceinline__ void xcd_barrier(const XcdBarrier& b) {
    asm volatile("s_waitcnt vmcnt(0)" ::: "memory");
    __syncthreads();
    if (threadIdx.x == 0) {
        unsigned* bar = b.bar;
        __builtin_amdgcn_s_waitcnt(0);
        unsigned nloc = b.st[0], nx = b.st[1];
        if (nloc == 0u) { xcd_barrier_complete(bar, b.x, nloc, nx); b.st[0] = nloc; b.st[1] = nx; }
        const unsigned old = xb_add(&bar[XB_XSUB(b.x)], 1u);
        const unsigned gen = old / nloc;
        if (old + 1u == (gen + 1u) * nloc) {
            __builtin_amdgcn_fence(__ATOMIC_RELEASE, "agent");
            asm volatile("s_waitcnt vmcnt(0)" ::: "memory");
            const unsigned og = xb_add(&bar[XB_TOP], 1u);
            const unsigned tg = og / nx;
            if (og + 1u == (tg + 1u) * nx) xb_add(&bar[XB_TOPGEN], 1u);
            else XB_SPIN(xb_ld(&bar[XB_TOPGEN]) == tg, bar);
            __builtin_amdgcn_fence(__ATOMIC_ACQUIRE, "agent");
            xb_add(&bar[XB_XGEN(b.x)], 1u);
            asm volatile("s_waitcnt vmcnt(0)" ::: "memory");
        } else {
            XB_SPIN(xb_ld(&bar[XB_XGEN(b.x)]) == gen, bar);
            __builtin_amdgcn_fence(__ATOMIC_ACQUIRE, "agent");
            asm volatile("s_waitcnt vmcnt(0)" ::: "memory");
        }
    }
    __syncthreads();
}

struct Frame {
    LAS unsigned char* lds;
    volatile LAS unsigned* MISC;
    gu32* ctl;
    int tid, lane, wave;
    int vcu, G;
    unsigned char* ws;
    const float* x; float* out;
    const float *ln1_g, *w_in, *w_bsb, *w_bhg, *hg_norm_g, *lbl, *w_out, *ln2_g, *w_rg, *b_rg, *w_re, *b_re, *w_eg, *w_eu, *w_ed, *final_g;
    volatile LAS unsigned long long* PT;
};
__device__ __forceinline__ const float* fin(const Frame& F, int k) { const unsigned long long v = F.PT[k]; const unsigned lo = __builtin_amdgcn_readfirstlane((unsigned)v), hi = __builtin_amdgcn_readfirstlane((unsigned)(v >> 32)); return (const float*)(const GAS float*)(((unsigned long long)hi << 32) | lo); }
__device__ __forceinline__ float wave_sum(float v) {
#pragma unroll
    for (int o = 1; o < 64; o <<= 1) v += __shfl_xor(v, o);
    return v;
}

struct CvItem { const float* src; bf16* dst; int N, K; };
__device__ __forceinline__ void cv_load(const CvItem& c, f32x4 (&v)[8], int lane) {
    const GAS float* p = (const GAS float*)c.src + (size_t)(lane >> 3) * c.N + (lane & 7) * 4;
#pragma unroll
    for (int i = 0; i < 8; ++i) v[i] = *(const GAS f32x4*)(p + (size_t)(8 * i) * c.N);
}
__device__ __forceinline__ void cv_finish(const CvItem& c, const f32x4 (&v)[8], LAS float* scr, int lane) {
#pragma unroll
    for (int i = 0; i < 8; ++i) { LAS float* d = scr + ((lane >> 3) + 8 * i) * 33 + (lane & 7) * 4; d[0] = v[i].x; d[1] = v[i].y; d[2] = v[i].z; d[3] = v[i].w; }
    LDS_WAIT(); asm volatile("" ::: "memory");
    const int cc = lane & 7;
#pragma unroll
    for (int j = 0; j < 4; ++j) { const int n = (lane >> 3) + 8 * j; const LAS float* s = scr + (8 * cc) * 33 + n;
        v4u o; o.x = pk2(s[0 * 33], s[1 * 33]); o.y = pk2(s[2 * 33], s[3 * 33]); o.z = pk2(s[4 * 33], s[5 * 33]); o.w = pk2(s[6 * 33], s[7 * 33]);
        *(GAS v4u*)(c.dst + (size_t)n * c.K + 8 * cc) = o; }
    LDS_WAIT(); asm volatile("" ::: "memory");
}
constexpr int CV_IN = 16 * 176, CV_BR = 8 * 32, CV_OUT = 16 * 32, CV_G = 16 * 16 * 16, CV_D = 16 * 8 * 32;
constexpr int N_EARLY = CV_IN + 2 * CV_BR + CV_OUT, N_LATE = 2 * CV_G + CV_D;
__device__ __forceinline__ CvItem cv_decode(const Frame& F, int it) {
    bf16* WinT = (bf16*)(F.ws + WS_WIN); bf16* WbrT = (bf16*)(F.ws + WS_WBR); bf16* WoutT = (bf16*)(F.ws + WS_WOUT); bf16* W1 = (bf16*)(F.ws + WS_W1); bf16* WdT = (bf16*)(F.ws + WS_WD);
    int r = it;
    if (r < CV_IN) { const int kb = r / 176, nb = r % 176, n0 = nb * 32; int drow = n0;
        if (n0 >= 4608) { const int c = n0 - 4608; drow = 3584 + (c >> 7) * 256 + 128 + (c & 127); } else if (n0 >= 3584) { const int c = n0 - 3584; drow = 3584 + (c >> 7) * 256 + (c & 127); }
        return CvItem{F.w_in + (size_t)(64 * kb) * IN_COLS + n0, WinT + (size_t)drow * 1024 + 64 * kb, IN_COLS, 1024}; } r -= CV_IN;
    if (r < CV_BR) { const int kb = r / 32, nb = r % 32; return CvItem{F.w_bsb + (size_t)(64 * kb) * 1024 + nb * 32, WbrT + (size_t)(nb * 32) * 512 + 64 * kb, 1024, 512}; } r -= CV_BR;
    if (r < CV_BR) { const int kb = r / 32, nb = r % 32; return CvItem{F.w_bhg + (size_t)(64 * kb) * 1024 + nb * 32, WbrT + (size_t)(1024 + nb * 32) * 512 + 64 * kb, 1024, 512}; } r -= CV_BR;
    if (r < CV_OUT) { const int kb = r / 32, nb = r % 32; return CvItem{F.w_out + (size_t)(64 * kb) * 1024 + nb * 32, WoutT + (size_t)(nb * 32) * 1024 + 64 * kb, 1024, 1024}; } r -= CV_OUT;
    if (r < 2 * CV_G) { const int up = r >= CV_G; if (up) r -= CV_G; const int e = r / 256, q = r % 256, kb = q / 16, nb = q % 16, n0 = nb * 32;
        const int drow = e * 1024 + (n0 >> 7) * 256 + (n0 & 127) + (up ? 128 : 0);
        return CvItem{(up ? F.w_eu : F.w_eg) + (size_t)e * 1024 * 512 + (size_t)(64 * kb) * 512 + n0, W1 + (size_t)drow * 1024 + 64 * kb, 512, 1024}; } r -= 2 * CV_G;
    { const int e = r / 256, q = r % 256, kb = q / 32, nb = q % 32;
      return CvItem{F.w_ed + (size_t)e * 512 * 1024 + (size_t)(64 * kb) * 1024 + nb * 32, WdT + (size_t)(e * 1024 + nb * 32) * 512 + 64 * kb, 1024, 512}; }
}
__device__ __forceinline__ void convert_range(const Frame& F, int first, int end, int stride, int base, LAS float* scr) {
    int it = first; if (it >= end) return;
    const int lane = F.lane;
    CvItem c = cv_decode(F, base + it); f32x4 v[8]; cv_load(c, v, lane);
    for (;;) {
        const int itn = it + stride;
        if (itn < end) { const CvItem cn = cv_decode(F, base + itn); f32x4 vn[8]; cv_load(cn, vn, lane); cv_finish(c, v, scr, lane); c = cn;
#pragma unroll
            for (int i = 0; i < 8; ++i) v[i] = vn[i];
            it = itn; }
        else { cv_finish(c, v, scr, lane); break; }
    }
}
__device__ __forceinline__ void p0_prologue(Frame& F) {
    LAS float* scr = (LAS float*)(F.lds + F.wave * 16384);
    const int gw = F.vcu * NWAVES + F.wave, NGW = F.G * NWAVES;
    convert_range(F, gw, N_EARLY, NGW, 0, scr);
    bf16* XN = (bf16*)(F.ws + WS_XN);
    f32x4 gv[4];
#pragma unroll
    for (int j = 0; j < 4; ++j) gv[j] = ((const GAS f32x4*)F.ln1_g)[F.lane + 64 * j];
    for (int m = gw; m < M; m += NGW) {
        const GAS f32x4* xr = (const GAS f32x4*)(F.x + (size_t)m * D) + F.lane;
        f32x4 v[4]; float s = 0.f;
#pragma unroll
        for (int j = 0; j < 4; ++j) { v[j] = xr[64 * j]; s += (v[j].x * v[j].x + v[j].y * v[j].y) + (v[j].z * v[j].z + v[j].w * v[j].w); }
        const float rstd = 1.0f / sqrtf(wave_sum(s) * (1.f / D) + EPS);
        GAS unsigned long long* o8 = (GAS unsigned long long*)(XN + (size_t)m * D) + F.lane;
#pragma unroll
        for (int j = 0; j < 4; ++j) { const f32x4 t = v[j] * rstd * gv[j]; o8[64 * j] = (unsigned long long)pk2(t.x, t.y) | ((unsigned long long)pk2(t.z, t.w) << 32); }
    }
}

typedef float f32x16 __attribute__((ext_vector_type(16)));
typedef short bf16x8v __attribute__((ext_vector_type(8)));
typedef short s16x4 __attribute__((ext_vector_type(4)));
typedef short v4i16_t __attribute__((ext_vector_type(4)));
__device__ __forceinline__ s16x4 vtr(const LAS unsigned char* p) { return __builtin_bit_cast(s16x4, __builtin_amdgcn_ds_read_tr16_b64_v4i16((LAS v4i16_t*)p)); }
__device__ __forceinline__ unsigned cvtpk(float lo, float hi) { typedef float f2 __attribute__((ext_vector_type(2))); typedef __bf16 b2 __attribute__((ext_vector_type(2))); f2 v = {lo, hi}; return __builtin_bit_cast(unsigned, __builtin_convertvector(v, b2)); }
__device__ __forceinline__ void sb_attn_unit_mfma(Frame& F, int unit, bf16* Ydst) {
    const int lane = F.lane, r32 = lane & 31, hi = lane >> 5;
    const int bh = unit >> 8, qb = unit & 255, b = bh >> 3, h = bh & 7, t0 = qb * 32;
    bf16* Qs = (bf16*)(F.ws + WS_QS); const bf16* Kb = (const bf16*)(F.ws + WS_KS) + (size_t)(b * SEQ) * HW + h * 64; const bf16* Vb = (const bf16*)(F.ws + WS_VS) + (size_t)(b * SEQ) * HW + h * 64;
    LAS unsigned char* vl = F.lds + F.wave * 8192;
    bf16x8v qf[4];
    { const bf16* Qg = Qs + (size_t)(b * SEQ + t0 + r32) * HW + h * 64 + hi * 8;
#pragma unroll
      for (int d0 = 0; d0 < 4; ++d0) qf[d0] = *(const bf16x8v*)(Qg + d0 * 16); }
    const int trow = t0 + r32;
    const int ktd = t0 >> 6;
    int kt = ktd;
    bf16x8v kf[8]; v4u vf[8];
#define SB_LOADK(T) do { const bf16* kp_ = Kb + (size_t)((T) * 64 + r32) * HW + hi * 8; _Pragma("unroll") for (int d0 = 0; d0 < 4; ++d0) { kf[d0] = *(const bf16x8v*)(kp_ + d0 * 16); kf[4 + d0] = *(const bf16x8v*)(kp_ + (size_t)32 * HW + d0 * 16); } } while (0)
#define SB_LOADV(T) do { const bf16* vp_ = Vb + (size_t)((T) * 64 + (lane >> 2)) * HW + (lane & 3) * 8; _Pragma("unroll") for (int p = 0; p < 8; ++p) vf[p] = *(const v4u*)(vp_ + (size_t)(16 * (p & 3)) * HW + (p >> 2) * 32); } while (0)
    SB_LOADK(kt); SB_LOADV(kt);
    f32x16 o0, o1;
#pragma unroll
    for (int r = 0; r < 16; ++r) { o0[r] = 0.f; o1[r] = 0.f; }
    float C = 1.0f;
    const LAS unsigned char* vb = vl + ((lane >> 4) & 1) * 32 + (lane & 3) * 8 + (4 * hi + ((lane & 15) >> 2)) * 64;
    constexpr float SC = 0.125f * 1.4426950408889634f, EXITP = 9.3576e-14f;
    for (;;) {
        f32x16 p0, p1;
#pragma unroll
        for (int r = 0; r < 16; ++r) { p0[r] = 0.f; p1[r] = 0.f; }
#pragma unroll
        for (int d0 = 0; d0 < 4; ++d0) { p0 = __builtin_amdgcn_mfma_f32_32x32x16_bf16(kf[d0], qf[d0], p0, 0, 0, 0); p1 = __builtin_amdgcn_mfma_f32_32x32x16_bf16(kf[4 + d0], qf[d0], p1, 0, 0, 0); }
#pragma unroll
        for (int p = 0; p < 8; ++p) *(LAS v4u*)(vl + p * 1024 + lane * 16) = vf[p];
        const int k0 = kt * 64; const bool diag = (kt == ktd);
        { const int ktn = kt > 0 ? kt - 1 : 0; SB_LOADK(ktn); SB_LOADV(ktn); }
        float s0[16], s1[16];
#pragma unroll
        for (int r = 0; r < 16; ++r) { p0[r] = __builtin_amdgcn_rcpf(1.0f + __builtin_amdgcn_exp2f(-p0[r] * SC)); p1[r] = __builtin_amdgcn_rcpf(1.0f + __builtin_amdgcn_exp2f(-p1[r] * SC)); s0[r] = 1.0f - p0[r]; s1[r] = 1.0f - p1[r]; }
        if (diag) {
#pragma unroll
            for (int r = 0; r < 16; ++r) { const int key = k0 + (r & 3) + 8 * (r >> 2) + 4 * hi; if (!(key < trow)) { p0[r] = 0.f; s0[r] = 1.0f; } if (!(key + 32 < trow)) { p1[r] = 0.f; s1[r] = 1.0f; } }
        }
#pragma unroll
        for (int rb = 0; rb < 4; ++rb) { s0[4 * rb + 2] *= s0[4 * rb + 3]; s0[4 * rb + 1] *= s0[4 * rb + 2]; s0[4 * rb] *= s0[4 * rb + 1];
                                         s1[4 * rb + 2] *= s1[4 * rb + 3]; s1[4 * rb + 1] *= s1[4 * rb + 2]; s1[4 * rb] *= s1[4 * rb + 1]; }
        float off0[4], off1[4]; float run = C;
#pragma unroll
        for (int rb = 3; rb >= 0; --rb) { const float me = s1[4 * rb], ot = __shfl_xor(me, 32); off1[rb] = run * (hi == 0 ? ot : 1.0f); run *= me * ot; }
#pragma unroll
        for (int rb = 3; rb >= 0; --rb) { const float me = s0[4 * rb], ot = __shfl_xor(me, 32); off0[rb] = run * (hi == 0 ? ot : 1.0f); run *= me * ot; }
#pragma unroll
        for (int rb = 0; rb < 4; ++rb) {
            p0[4 * rb] *= s0[4 * rb + 1] * off0[rb]; p0[4 * rb + 1] *= s0[4 * rb + 2] * off0[rb]; p0[4 * rb + 2] *= s0[4 * rb + 3] * off0[rb]; p0[4 * rb + 3] *= off0[rb];
            p1[4 * rb] *= s1[4 * rb + 1] * off1[rb]; p1[4 * rb + 1] *= s1[4 * rb + 2] * off1[rb]; p1[4 * rb + 2] *= s1[4 * rb + 3] * off1[rb]; p1[4 * rb + 3] *= off1[rb]; }
        C = run;
        v4u pw[4];
        pw[0] = (v4u){cvtpk(p0[0], p0[1]), cvtpk(p0[2], p0[3]), cvtpk(p0[4], p0[5]), cvtpk(p0[6], p0[7])};
        pw[1] = (v4u){cvtpk(p0[8], p0[9]), cvtpk(p0[10], p0[11]), cvtpk(p0[12], p0[13]), cvtpk(p0[14], p0[15])};
        pw[2] = (v4u){cvtpk(p1[0], p1[1]), cvtpk(p1[2], p1[3]), cvtpk(p1[4], p1[5]), cvtpk(p1[6], p1[7])};
        pw[3] = (v4u){cvtpk(p1[8], p1[9]), cvtpk(p1[10], p1[11]), cvtpk(p1[12], p1[13]), cvtpk(p1[14], p1[15])};
#pragma unroll
        for (int ks = 0; ks < 4; ++ks) {
            const s16x4 l0 = vtr(vb + ks * 1024), h0 = vtr(vb + ks * 1024 + 512), l1 = vtr(vb + 4096 + ks * 1024), h1 = vtr(vb + 4096 + ks * 1024 + 512);
            const bf16x8v b0 = (bf16x8v){l0[0], l0[1], l0[2], l0[3], h0[0], h0[1], h0[2], h0[3]}, b1 = (bf16x8v){l1[0], l1[1], l1[2], l1[3], h1[0], h1[1], h1[2], h1[3]};
            const bf16x8v pa = __builtin_bit_cast(bf16x8v, pw[ks]);
            o0 = __builtin_amdgcn_mfma_f32_32x32x16_bf16(pa, b0, o0, 0, 0, 0); o1 = __builtin_amdgcn_mfma_f32_32x32x16_bf16(pa, b1, o1, 0, 0, 0);
        }
        if (kt == 0) break;
        if (__all(C < EXITP)) break;
        --kt;
    }
#undef SB_LOADK
#undef SB_LOADV
    { bf16* yp = Ydst + (size_t)(b * SEQ + t0) * HW + h * 64 + r32;
#pragma unroll
      for (int r = 0; r < 16; ++r) { const int q = (r & 3) + 8 * (r >> 2) + 4 * hi; yp[(size_t)q * HW] = (bf16)f2bf(o0[r]); yp[(size_t)q * HW + 32] = (bf16)f2bf(o1[r]); } }
    LDS_WAIT();
}

__device__ __forceinline__ void hg_scan(Frame& F, int blk) {
    if (F.tid >= 256) return;
    const int gid = blk * 256 + F.tid;
    const int bh = gid >> 12, vk = gid & 4095, k = vk & 63;
    const bf16* S = (const bf16*)(F.ws + WS_XN) + (size_t)bh * 128 * 4096 + vk; const float* dec = (const float*)(F.ws + WS_SMALL + SM_DEC) + (size_t)(bh >> 3) * 128 * 512 + (bh & 7) * 64 + k;
    bf16* O = (bf16*)(F.ws + WS_SIN) + (size_t)bh * 128 * 4096 + vk;
    float run = 0.f;
    for (int c0 = 0; c0 < 128; c0 += 16) {
        float loc[16], d[16];
#pragma unroll
        for (int i = 0; i < 16; ++i) { loc[i] = bf2f(S[(size_t)(c0 + i) * 4096]); d[i] = dec[(c0 + i) * 512]; }
#pragma unroll
        for (int i = 0; i < 16; ++i) { O[(size_t)(c0 + i) * 4096] = (bf16)f2bf(run); run = run * d[i] + loc[i]; }
    }
}

template <int CTRL> __device__ __forceinline__ float dppf(float v) { return __builtin_bit_cast(float, __builtin_amdgcn_update_dpp(0, __builtin_bit_cast(int, v), CTRL, 0xF, 0xF, true)); }
__device__ __forceinline__ bf16x8v trfrag(const LAS unsigned char* p) { const s16x4 l = vtr(p), h = vtr(p + 512); return (bf16x8v){l[0], l[1], l[2], l[3], h[0], h[1], h[2], h[3]}; }
__device__ __forceinline__ void zero16(f32x16& a) {
#pragma unroll
    for (int r = 0; r < 16; ++r) a[r] = 0.f;
}
__device__ __forceinline__ void hg_local_mfma(Frame& F, int unit) {
    int lane_ = F.lane; asm volatile("" : "+v"(lane_));
    const int bh = unit >> 7, c = unit & 127, b = bh >> 3, h = bh & 7; const int lane = lane_, r32 = lane & 31, hi = lane >> 5;
    const size_t row0 = (size_t)b * SEQ + (size_t)c * 64;
    LAS unsigned char* kdI = F.lds + F.wave * 16384; LAS unsigned char* vI = kdI + 8192;
    { const bf16* vp_ = (const bf16*)(F.ws + WS_VH) + (row0 + (lane >> 2)) * HW + h * 64 + (lane & 3) * 8;
#pragma unroll
      for (int p = 0; p < 8; ++p) { const v4u t = *(const v4u*)(vp_ + (size_t)(16 * (p & 3)) * HW + (p >> 2) * 32); *(LAS v4u*)(vI + p * 1024 + lane * 16) = t; } }
    {
        const int k0 = (lane & 7) * 8, sr = lane >> 3;
        const bf16* kp = (const bf16*)(F.ws + WS_KH) + row0 * HW + h * 64 + k0;
#pragma unroll
        for (int i = 0; i < 8; ++i) { const int s2 = sr + 8 * i; const v4u kk = *(const v4u*)(kp + (size_t)s2 * HW);
            *(LAS v4u*)(kdI + ((k0 >> 5) * 4 + (s2 >> 4)) * 1024 + (s2 & 15) * 64 + (k0 & 31) * 2) = kk; }
    }
    const float* elm = (const float*)(F.ws + WS_SMALL + SM_ELM) + (size_t)(b * 128 + c) * 512 + h * 64 + r32;
    const float e0 = elm[0], e1 = elm[32];
    LDS_WAIT();
    const int vb = ((lane >> 4) & 1) * 32 + (lane & 3) * 8 + (4 * hi + ((lane & 15) >> 2)) * 64;
    f32x16 a00, a01, a10, a11; zero16(a00); zero16(a01); zero16(a10); zero16(a11);
#pragma unroll
    for (int ks = 0; ks < 4; ++ks) {
        const bf16x8v k0 = trfrag(kdI + vb + ks * 1024), k1 = trfrag(kdI + vb + 4096 + ks * 1024), v0 = trfrag(vI + vb + ks * 1024), v1 = trfrag(vI + vb + 4096 + ks * 1024);
        a00 = __builtin_amdgcn_mfma_f32_32x32x16_bf16(v0, k0, a00, 0, 0, 0); a01 = __builtin_amdgcn_mfma_f32_32x32x16_bf16(v0, k1, a01, 0, 0, 0);
        a10 = __builtin_amdgcn_mfma_f32_32x32x16_bf16(v1, k0, a10, 0, 0, 0); a11 = __builtin_amdgcn_mfma_f32_32x32x16_bf16(v1, k1, a11, 0, 0, 0);
    }
    bf16* Sl = (bf16*)(F.ws + WS_XN) + (size_t)unit * 4096 + r32;
#pragma unroll
    for (int r = 0; r < 16; ++r) { const int v = (r & 3) + 8 * (r >> 2) + 4 * hi;
        Sl[v * 64] = (bf16)f2bf(a00[r] * e0); Sl[v * 64 + 32] = (bf16)f2bf(a01[r] * e1); Sl[(v + 32) * 64] = (bf16)f2bf(a10[r] * e0); Sl[(v + 32) * 64 + 32] = (bf16)f2bf(a11[r] * e1); }
    LDS_WAIT();
}
__device__ __forceinline__ void hg_out_mfma(Frame& F, int unit) {
    int lane_ = F.lane; asm volatile("" : "+v"(lane_));
    const int bh = unit >> 7, c = unit & 127, b = bh >> 3, h = bh & 7; const int lane = lane_, r32 = lane & 31, hi = lane >> 5;
    const size_t row0 = (size_t)b * SEQ + (size_t)c * 64;
    LAS unsigned char* img = F.lds + F.wave * 8192;
    { const bf16* vp_ = (const bf16*)(F.ws + WS_VH) + (row0 + (lane >> 2)) * HW + h * 64 + (lane & 3) * 8;
#pragma unroll
      for (int p = 0; p < 8; ++p) { const v4u t = *(const v4u*)(vp_ + (size_t)(16 * (p & 3)) * HW + (p >> 2) * 32); *(LAS v4u*)(img + p * 1024 + lane * 16) = t; } }
    const bf16* SinT = (const bf16*)(F.ws + WS_SIN) + (size_t)unit * 4096 + (size_t)r32 * 64 + 8 * hi;
    const bf16* eap = (const bf16*)(F.ws + WS_LOGF) + row0 * HW + h * 64 + 8 * hi;
    const bf16* qp = (const bf16*)(F.ws + WS_QH) + row0 * HW + h * 64 + 8 * hi;
    const bf16* kp = (const bf16*)(F.ws + WS_KH) + row0 * HW + h * 64 + 8 * hi;
    const float* emp = (const float*)(F.ws + WS_SMALL + SM_EMID) + (size_t)(b * 128 + c) * 512 + h * 64 + 8 * hi;
    bf16x8v Af[2][4], Bf[2][4];
    f32x16 o00, o01, o10, o11; zero16(o00); zero16(o01); zero16(o10); zero16(o11);
#pragma unroll
    for (int ks = 0; ks < 4; ++ks) {
        const f32x4 e0_ = *(const f32x4*)(emp + 16 * ks), e1_ = *(const f32x4*)(emp + 16 * ks + 4);
        const float em[8] = {e0_.x, e0_.y, e0_.z, e0_.w, e1_.x, e1_.y, e1_.z, e1_.w};
        const bf16x8v sf0 = *(const bf16x8v*)(SinT + 16 * ks), sf1 = *(const bf16x8v*)(SinT + 32 * 64 + 16 * ks);
        bf16x8v As[2];
#pragma unroll
        for (int rb = 0; rb < 2; ++rb) { const size_t ro = (size_t)(32 * rb + r32) * HW + 16 * ks;
            const v4u qq = *(const v4u*)(qp + ro), kk = *(const v4u*)(kp + ro), ee = *(const v4u*)(eap + ro);
            const float a[8] = {blo(qq.x) * blo(ee.x), bhi(qq.x) * bhi(ee.x), blo(qq.y) * blo(ee.y), bhi(qq.y) * bhi(ee.y), blo(qq.z) * blo(ee.z), bhi(qq.z) * bhi(ee.z), blo(qq.w) * blo(ee.w), bhi(qq.w) * bhi(ee.w)};
            const v4u wa = (v4u){cvtpk(a[0], a[1]), cvtpk(a[2], a[3]), cvtpk(a[4], a[5]), cvtpk(a[6], a[7])};
            const v4u wb = kk;
            const v4u ws_ = (v4u){cvtpk(a[0] * em[0], a[1] * em[1]), cvtpk(a[2] * em[2], a[3] * em[3]), cvtpk(a[4] * em[4], a[5] * em[5]), cvtpk(a[6] * em[6], a[7] * em[7])};
            Af[rb][ks] = __builtin_bit_cast(bf16x8v, wa); Bf[rb][ks] = __builtin_bit_cast(bf16x8v, wb); As[rb] = __builtin_bit_cast(bf16x8v, ws_); }
        o00 = __builtin_amdgcn_mfma_f32_32x32x16_bf16(As[0], sf0, o00, 0, 0, 0); o01 = __builtin_amdgcn_mfma_f32_32x32x16_bf16(As[0], sf1, o01, 0, 0, 0);
        o10 = __builtin_amdgcn_mfma_f32_32x32x16_bf16(As[1], sf0, o10, 0, 0, 0); o11 = __builtin_amdgcn_mfma_f32_32x32x16_bf16(As[1], sf1, o11, 0, 0, 0);

    }
    f32x16 s00, s01, s11; zero16(s00); zero16(s01); zero16(s11);
#pragma unroll
    for (int ks = 0; ks < 4; ++ks) { s00 = __builtin_amdgcn_mfma_f32_32x32x16_bf16(Bf[0][ks], Af[0][ks], s00, 0, 0, 0); s01 = __builtin_amdgcn_mfma_f32_32x32x16_bf16(Bf[0][ks], Af[1][ks], s01, 0, 0, 0);
        s11 = __builtin_amdgcn_mfma_f32_32x32x16_bf16(Bf[1][ks], Af[1][ks], s11, 0, 0, 0); }
#pragma unroll
    for (int r = 0; r < 16; ++r) { const int sl = (r & 3) + 8 * (r >> 2) + 4 * hi; if (sl > r32) { s00[r] = 0.f; s11[r] = 0.f; } }
    v4u p00[2], p01[2], p11[2];
#pragma unroll
    for (int k2 = 0; k2 < 2; ++k2) {
        p00[k2] = (v4u){cvtpk(s00[8 * k2], s00[8 * k2 + 1]), cvtpk(s00[8 * k2 + 2], s00[8 * k2 + 3]), cvtpk(s00[8 * k2 + 4], s00[8 * k2 + 5]), cvtpk(s00[8 * k2 + 6], s00[8 * k2 + 7])};
        p01[k2] = (v4u){cvtpk(s01[8 * k2], s01[8 * k2 + 1]), cvtpk(s01[8 * k2 + 2], s01[8 * k2 + 3]), cvtpk(s01[8 * k2 + 4], s01[8 * k2 + 5]), cvtpk(s01[8 * k2 + 6], s01[8 * k2 + 7])};
        p11[k2] = (v4u){cvtpk(s11[8 * k2], s11[8 * k2 + 1]), cvtpk(s11[8 * k2 + 2], s11[8 * k2 + 3]), cvtpk(s11[8 * k2 + 4], s11[8 * k2 + 5]), cvtpk(s11[8 * k2 + 6], s11[8 * k2 + 7])};
    }
    LDS_WAIT();
    const int vb = ((lane >> 4) & 1) * 32 + (lane & 3) * 8 + (4 * hi + ((lane & 15) >> 2)) * 64;
#pragma unroll
    for (int k2 = 0; k2 < 2; ++k2) {
        const bf16x8v v0a = trfrag(img + vb + k2 * 1024), v1a = trfrag(img + vb + 4096 + k2 * 1024);
        const bf16x8v v0b = trfrag(img + vb + (2 + k2) * 1024), v1b = trfrag(img + vb + 4096 + (2 + k2) * 1024);
        const bf16x8v a00 = __builtin_bit_cast(bf16x8v, p00[k2]), a01 = __builtin_bit_cast(bf16x8v, p01[k2]), a11 = __builtin_bit_cast(bf16x8v, p11[k2]);
        o00 = __builtin_amdgcn_mfma_f32_32x32x16_bf16(a00, v0a, o00, 0, 0, 0); o01 = __builtin_amdgcn_mfma_f32_32x32x16_bf16(a00, v1a, o01, 0, 0, 0);
        o10 = __builtin_amdgcn_mfma_f32_32x32x16_bf16(a01, v0a, o10, 0, 0, 0); o11 = __builtin_amdgcn_mfma_f32_32x32x16_bf16(a01, v1a, o11, 0, 0, 0);
        o10 = __builtin_amdgcn_mfma_f32_32x32x16_bf16(a11, v0b, o10, 0, 0, 0); o11 = __builtin_amdgcn_mfma_f32_32x32x16_bf16(a11, v1b, o11, 0, 0, 0);
    }
    LDS_WAIT();
    { LAS bf16* ot = (LAS bf16*)img + r32;
#pragma unroll
      for (int r = 0; r < 16; ++r) { const int t = (r & 3) + 8 * (r >> 2) + 4 * hi;
          ot[t * 64] = (bf16)f2bf(o00[r]); ot[t * 64 + 32] = (bf16)f2bf(o01[r]); ot[(t + 32) * 64] = (bf16)f2bf(o10[r]); ot[(t + 32) * 64 + 32] = (bf16)f2bf(o11[r]); } }
    LDS_WAIT();
    { int lane2 = lane; asm volatile("" : "+v"(lane2));
      const int v0e = (lane2 & 7) * 8, tre = lane2 >> 3; const bf16* ghp = (const bf16*)(F.ws + WS_GH) + row0 * HW + h * 64 + v0e;
      const f32x4 g0 = *(const f32x4*)(F.hg_norm_g + h * 64 + v0e), g1 = *(const f32x4*)(F.hg_norm_g + h * 64 + v0e + 4);
      bf16* yp = (bf16*)(F.ws + WS_KS) + row0 * HW + h * 64 + v0e;
#pragma unroll
      for (int i = 0; i < 8; ++i) { const int t = tre + 8 * i;
          const v4u ov = *(const LAS v4u*)(img + t * 128 + v0e * 2); const v4u gg = *(const v4u*)(ghp + (size_t)t * HW);
          const float o[8] = {blo(ov.x), bhi(ov.x), blo(ov.y), bhi(ov.y), blo(ov.z), bhi(ov.z), blo(ov.w), bhi(ov.w)};
          float q = (o[0] * o[0] + o[1] * o[1]) + (o[2] * o[2] + o[3] * o[3]) + (o[4] * o[4] + o[5] * o[5]) + (o[6] * o[6] + o[7] * o[7]);
          q += dppf<0xB1>(q); q += dppf<0x4E>(q); q += dppf<0x141>(q);
          const float rs = 1.0f / sqrtf(q * (1.f / 64.f) + EPS);
          v4u w; w.x = cvtpk(o[0] * rs * g0.x * blo(gg.x), o[1] * rs * g0.y * bhi(gg.x)); w.y = cvtpk(o[2] * rs * g0.z * blo(gg.y), o[3] * rs * g0.w * bhi(gg.y));
          w.z = cvtpk(o[4] * rs * g1.x * blo(gg.z), o[5] * rs * g1.y * bhi(gg.z)); w.w = cvtpk(o[6] * rs * g1.z * blo(gg.w), o[7] * rs * g1.w * bhi(gg.w));
          *(v4u*)(yp + (size_t)t * HW) = w; } }
    LDS_WAIT();
}

__device__ __forceinline__ void router_phase(Frame& F) {
    LAS float* xs = (LAS float*)(F.lds + F.wave * 11136);
    LAS float* We = xs + 64 * 33;
    LAS float* Wg = We + 32 * 16;
    LAS float* Gc = Wg + 32 * 4;
    LAS float* part = (LAS float*)(F.lds + 8 * 11136);
    LAS int* lh = (LAS int*)(F.lds + 8 * 11136 + 8 * 21 * 64 * 4);
    LAS float* lrs = (LAS float*)(lh + 16);
    const int lane = F.lane;
    int* tok_e = (int*)(F.ws + WS_SMALL + SM_TOKE); float* tok_w = (float*)(F.ws + WS_SMALL + SM_TOKW); float* tok_r = (float*)(F.ws + WS_SMALL + SM_RSTD);
    for (int blk = F.vcu; blk < M / 64; blk += F.G) {
        if (F.tid < 16) lh[F.tid] = 0;
        float ss = 0.f, ag[4] = {0.f, 0.f, 0.f, 0.f}, ae[16];
#pragma unroll
        for (int j = 0; j < 16; ++j) ae[j] = 0.f;
        const bf16* xb = (const bf16*)(F.ws + WS_X1) + (size_t)(blk * 64) * D + F.wave * 128;
        v4u v[4]; f32x4 we0, we1, wg, gg;
#define RT_LOAD(CH) do { const int c0_ = F.wave * 128 + (CH) * 32; \
            _Pragma("unroll") for (int j = 0; j < 4; ++j) v[j] = *(const GAS v4u*)(xb + (size_t)((lane >> 2) + 16 * j) * D + (CH) * 32 + (lane & 3) * 8); \
            we0 = *(const GAS f32x4*)(F.w_re + (size_t)c0_ * 16 + lane * 4); we1 = *(const GAS f32x4*)(F.w_re + (size_t)c0_ * 16 + 256 + lane * 4); \
            wg = *(const GAS f32x4*)(F.w_rg + (size_t)c0_ * 4 + (lane & 31) * 4); gg = *(const GAS f32x4*)(F.ln2_g + c0_ + (lane & 7) * 4); } while (0)
        RT_LOAD(0);
        for (int ch = 0; ch < 4; ++ch) {
#pragma unroll
            for (int j = 0; j < 4; ++j) { LAS float* d = xs + ((lane >> 2) + 16 * j) * 33 + (lane & 3) * 8; d[0] = blo(v[j].x); d[1] = bhi(v[j].x); d[2] = blo(v[j].y); d[3] = bhi(v[j].y); d[4] = blo(v[j].z); d[5] = bhi(v[j].z); d[6] = blo(v[j].w); d[7] = bhi(v[j].w); }
            *(LAS f32x4*)(We + lane * 4) = we0; *(LAS f32x4*)(We + 256 + lane * 4) = we1;
            if (lane < 32) *(LAS f32x4*)(Wg + lane * 4) = wg;
            if (lane < 8) *(LAS f32x4*)(Gc + lane * 4) = gg;
            LDS_WAIT();
            if (ch < 3) RT_LOAD(ch + 1);
#pragma unroll 4
            for (int cc = 0; cc < 32; ++cc) {
                const float xv = xs[lane * 33 + cc]; const float xg = xv * Gc[cc];
                ss += xv * xv;
                const f32x4 g4 = *(const LAS f32x4*)(Wg + cc * 4);
                ag[0] += xg * g4.x; ag[1] += xg * g4.y; ag[2] += xg * g4.z; ag[3] += xg * g4.w;
#pragma unroll
                for (int r = 0; r < 4; ++r) { const f32x4 e4 = *(const LAS f32x4*)(We + cc * 16 + 4 * r);
                    ae[4 * r] += xg * e4.x; ae[4 * r + 1] += xg * e4.y; ae[4 * r + 2] += xg * e4.z; ae[4 * r + 3] += xg * e4.w; }
            }
            LDS_WAIT();
        }
#undef RT_LOAD
        part[(F.wave * 21 + 0) * 64 + lane] = ss;
#pragma unroll
        for (int j = 0; j < 4; ++j) part[(F.wave * 21 + 1 + j) * 64 + lane] = ag[j];
#pragma unroll
        for (int j = 0; j < 16; ++j) part[(F.wave * 21 + 5 + j) * 64 + lane] = ae[j];
        __syncthreads();
        if (F.wave == 0) {
            const int tok = blk * 64 + lane;
            ss = 0.f;
#pragma unroll
            for (int j = 0; j < 4; ++j) ag[j] = 0.f;
#pragma unroll
            for (int j = 0; j < 16; ++j) ae[j] = 0.f;
#pragma unroll
            for (int w = 0; w < 8; ++w) { ss += part[(w * 21) * 64 + lane];
#pragma unroll
                for (int j = 0; j < 4; ++j) ag[j] += part[(w * 21 + 1 + j) * 64 + lane];
#pragma unroll
                for (int j = 0; j < 16; ++j) ae[j] += part[(w * 21 + 5 + j) * 64 + lane]; }
            const float rstd = 1.0f / sqrtf(ss * (1.f / D) + EPS);
            float gl[4];
#pragma unroll
            for (int j = 0; j < 4; ++j) gl[j] = ag[j] * rstd + F.b_rg[j];
            int gi = 0; float gm = gl[0];
#pragma unroll
            for (int j = 1; j < 4; ++j) if (gl[j] > gm) { gm = gl[j]; gi = j; }
            float den = 0.f;
#pragma unroll
            for (int j = 0; j < 4; ++j) den += __expf(gl[j] - gm);
            const float wgrp = 1.0f / den;
            float el[4];
#pragma unroll
            for (int q = 0; q < 4; ++q) { float v = ae[q]; float bb = F.b_re[q];
#pragma unroll
                for (int g2 = 1; g2 < 4; ++g2) { v = (gi == g2) ? ae[g2 * 4 + q] : v; bb = (gi == g2) ? F.b_re[g2 * 4 + q] : bb; }
                el[q] = v * rstd + bb; }
            int i0 = 0; float v0 = el[0];
#pragma unroll
            for (int q = 1; q < 4; ++q) if (el[q] > v0) { v0 = el[q]; i0 = q; }
            int i1 = -1; float v1 = 0.f;
#pragma unroll
            for (int q = 0; q < 4; ++q) if (q != i0 && (i1 < 0 || el[q] > v1)) { v1 = el[q]; i1 = q; }
            const float ex = __expf(v1 - v0); const float p0 = 1.0f / (1.0f + ex), p1 = ex / (1.0f + ex);
            const int e0 = gi * 4 + i0, e1 = gi * 4 + i1;
            *(v2u*)(tok_e + tok * 2) = (v2u){(unsigned)e0, (unsigned)e1};
            typedef float f32x2 __attribute__((ext_vector_type(2)));
            *(f32x2*)(tok_w + tok * 2) = (f32x2){p0 * wgrp, p1 * wgrp}; tok_r[tok] = rstd; lrs[lane] = rstd;
            __hip_atomic_fetch_add(&lh[e0], 1, __ATOMIC_RELAXED, __HIP_MEMORY_SCOPE_WORKGROUP); __hip_atomic_fetch_add(&lh[e1], 1, __ATOMIC_RELAXED, __HIP_MEMORY_SCOPE_WORKGROUP);
        }
        __syncthreads();
        if (F.tid < 16) ((int*)(F.ws + WS_SMALL + SM_HIST))[blk * 16 + F.tid] = lh[F.tid];
        {
            bf16* TN = (bf16*)(F.ws + WS_TS); f32x4 gq[4];
#pragma unroll
            for (int j = 0; j < 4; ++j) gq[j] = ((const GAS f32x4*)F.ln2_g)[lane + 64 * j];
            for (int i0 = 0; i0 < 8; i0 += 4) {
                v2u xv[4][4];
#pragma unroll
                for (int u = 0; u < 4; ++u) { const GAS v2u* xr = (const GAS v2u*)((const bf16*)(F.ws + WS_X1) + (size_t)(blk * 64 + F.wave * 8 + i0 + u) * D) + lane;
#pragma unroll
                    for (int j = 0; j < 4; ++j) xv[u][j] = xr[64 * j]; }
#pragma unroll
                for (int u = 0; u < 4; ++u) { const int tl = F.wave * 8 + i0 + u; const float rs = lrs[tl];
                    GAS unsigned long long* o0 = (GAS unsigned long long*)(TN + (size_t)(blk * 64 + tl) * D) + lane;
#pragma unroll
                    for (int j = 0; j < 4; ++j) { const f32x4 t = (f32x4){blo(xv[u][j].x), bhi(xv[u][j].x), blo(xv[u][j].y), bhi(xv[u][j].y)} * rs * gq[j]; o0[64 * j] = (unsigned long long)pk2(t.x, t.y) | ((unsigned long long)pk2(t.z, t.w) << 32); } }
            }
        }
        __syncthreads();
    }
}

__device__ __forceinline__ void sort_gather_phase(Frame& F) {
    LAS int* L = (LAS int*)(F.lds);
    const int* hist = (const int*)(F.ws + WS_SMALL + SM_HIST);
    int* rowtok = (int*)(F.ws + WS_SMALL + SM_ROWTOK); float* roww = (float*)(F.ws + WS_SMALL + SM_ROWW);
    const int* tok_e = (const int*)(F.ws + WS_SMALL + SM_TOKE); const float* tok_w = (const float*)(F.ws + WS_SMALL + SM_TOKW); const float* tok_r = (const float*)(F.ws + WS_SMALL + SM_RSTD);
    const int lane = F.lane;
    for (int blk = F.vcu; blk < M / 64; blk += F.G) {
        if (F.tid < 32) L[F.tid] = 0;
        __syncthreads();
        { const int e = F.tid & 15, bg = F.tid >> 4; int tot = 0, base = 0;
#pragma unroll
          for (int i = 0; i < 8; ++i) { const int b2 = bg + 32 * i; const int hv = hist[b2 * 16 + e]; tot += hv; base += (b2 < blk) ? hv : 0; }
          __hip_atomic_fetch_add(&L[e], tot, __ATOMIC_RELAXED, __HIP_MEMORY_SCOPE_WORKGROUP); __hip_atomic_fetch_add(&L[16 + e], base, __ATOMIC_RELAXED, __HIP_MEMORY_SCOPE_WORKGROUP); }
        __syncthreads();
        if (F.tid == 0) { int p = 0; for (int e = 0; e < 16; ++e) { L[32 + e] = p; L[64 + e] = p * 256; p += (L[e] + 255) >> 8; } L[48] = p;
            if (blk == 0) { int* meta = (int*)(F.ws + WS_SMALL + SM_META); for (int e = 0; e <= 16; ++e) meta[e] = L[32 + e]; } }
        __syncthreads();
        if (F.wave == 0) {
            int run[16];
#pragma unroll
            for (int e = 0; e < 16; ++e) run[e] = 0;
            for (int r = 0; r < 2; ++r) {
                const int i = r * 64 + lane, tok = blk * 64 + (i >> 1), slot = i & 1; const int e = tok_e[tok * 2 + slot]; int pos = 0;
#pragma unroll
                for (int ex = 0; ex < 16; ++ex) { const unsigned long long mk = __ballot(e == ex); const int below = __popcll(mk & ((1ull << lane) - 1ull));
                    if (e == ex) pos = L[64 + ex] + L[16 + ex] + run[ex] + below; run[ex] += __popcll(mk); }
                L[128 + i] = pos; rowtok[pos] = tok * 2 + slot; roww[pos] = tok_w[tok * 2 + slot];
            }
        }
        __syncthreads();
        if (blk < 16) {
            const int first = L[64 + blk] + L[blk], end = L[64 + blk] + (((L[blk] + 255) >> 8) << 8);
            for (int r = first + F.tid; r < end; r += NWAVES * 64) { rowtok[r] = -1; roww[r] = 0.f; }
        }
        __syncthreads();
    }
}

__device__ __forceinline__ void touch_expert_weights(Frame& F) {
    const GAS v4u* p = (const GAS v4u*)(F.ws + WS_W1) + (F.vcu * (NWAVES * 64) + F.tid);
    const int n = F.G * NWAVES * 64; constexpr int TOTAL = (int)((WS_XN - WS_W1) / 16);
    v4u acc = (v4u){0u, 0u, 0u, 0u};
    int i = F.vcu * (NWAVES * 64) + F.tid;
    for (; i + 7 * n < TOTAL; i += 8 * n, p += 8 * (size_t)n) { v4u t[8];
#pragma unroll
        for (int j = 0; j < 8; ++j) t[j] = p[(size_t)j * n];
#pragma unroll
        for (int j = 0; j < 8; ++j) acc ^= t[j]; }
    for (; i < TOTAL; i += n, p += n) acc ^= *p;
    if (acc.x == 0x9E3779B9u && acc.y == 0x7F4A7C15u && acc.z == 0x2545F491u && acc.w == 0x85EBCA6Bu) F.ctl[CW_BAR - 64] = 1u;
}

__device__ __forceinline__ void final_phase(Frame& F) {
    const int gw = F.vcu * NWAVES + F.wave, NGW = F.G * NWAVES; const int lane = F.lane;
    const bf16* Y0 = (const bf16*)(F.ws + WS_XN); const bf16* Y1 = (const bf16*)(F.ws + WS_Y1);
    f32x4 gv[4];
#pragma unroll
    for (int j = 0; j < 4; ++j) gv[j] = ((const GAS f32x4*)F.final_g)[lane + 64 * j];
    for (int m0 = gw; m0 < M; m0 += 2 * NGW) {
        f32x4 v[2][4]; float s[2];
#pragma unroll
        for (int u = 0; u < 2; ++u) { const int m = m0 + u * NGW;
            const GAS v2u* xr = (const GAS v2u*)((const bf16*)(F.ws + WS_X1) + (size_t)m * D) + lane;
            const GAS v2u* y0 = (const GAS v2u*)(Y0 + (size_t)m * D) + lane; const GAS v2u* y1 = (const GAS v2u*)(Y1 + (size_t)m * D) + lane;
            s[u] = 0.f;
#pragma unroll
            for (int j = 0; j < 4; ++j) { const v2u a = y0[64 * j], b2 = y1[64 * j], xw = xr[64 * j]; f32x4 t = (f32x4){blo(xw.x), bhi(xw.x), blo(xw.y), bhi(xw.y)};
                t.x += blo(a.x) + blo(b2.x); t.y += bhi(a.x) + bhi(b2.x); t.z += blo(a.y) + blo(b2.y); t.w += bhi(a.y) + bhi(b2.y);
                v[u][j] = t; s[u] += (t.x * t.x + t.y * t.y) + (t.z * t.z + t.w * t.w); } }
#pragma unroll
        for (int u = 0; u < 2; ++u) { const int m = m0 + u * NGW; GAS f32x4* xr = (GAS f32x4*)(F.out + (size_t)m * D) + lane;
            const float rstd = 1.0f / sqrtf(wave_sum(s[u]) * (1.f / D) + EPS);
#pragma unroll
            for (int j = 0; j < 4; ++j) xr[64 * j] = v[u][j] * rstd * gv[j]; }
    }
}

struct Args { const float* in[17]; float* out; unsigned char* ws; int ph_lo, ph_hi, li, pad; };
__global__ void __launch_bounds__(NWAVES * 64, 2) hybrid_fwd(Args args) {
    extern __shared__ __attribute__((aligned(16))) unsigned char lds[];
    Frame F;
    F.lds = (LAS unsigned char*)lds;
    F.MISC = (volatile LAS unsigned*)(F.lds + MISC_OFF);
    F.tid = threadIdx.x; F.lane = F.tid & 63; F.wave = __builtin_amdgcn_readfirstlane(F.tid >> 6);
    F.G = gridDim.x; { const int bx = blockIdx.x; F.vcu = (F.G % 8 == 0) ? (bx % 8) * (F.G / 8) + bx / 8 : bx; }
    unsigned char* ws = args.ws; F.ws = ws;
    F.ctl = (gu32*)(ws + WS_CTL);
    for (int u = F.tid; u < (LDS_BYTES - LDSCTL_OFF) / 4; u += NWAVES * 64) ((LAS unsigned*)(F.lds + LDSCTL_OFF))[u] = 0u;
    __syncthreads();
    F.PT = (volatile LAS unsigned long long*)(F.lds + LDSCTL_OFF + 512);
#pragma unroll
    for (int k = 0; k < 17; ++k) if (F.tid == k) F.PT[k] = (unsigned long long)args.in[k];
    __syncthreads();
    F.out = args.out;
    XcdBarrier bar; bar.bar = (unsigned*)(F.ctl + CW_BAR); bar.x = 0; bar.st = nullptr;
    if (N_LAUNCHES == 1) bar = xcd_barrier_post((unsigned*)(F.ctl + CW_BAR), F.MISC + 8);
#if defined(PROBE_A0)
#define TS_MARK(i) do { if (threadIdx.x == 0) ((volatile LAS unsigned long long*)(F.lds + LDSCTL_OFF + 1024))[(i)] = __builtin_amdgcn_s_memrealtime(); } while (0)
#else
#define TS_MARK(i) do {} while (0)
#endif
    int nbar = 0;
    TS_MARK(0);
#define GRID_BAR() do { if (N_LAUNCHES == 1) { TS_MARK(1 + 2 * nbar); xcd_barrier(bar); TS_MARK(2 + 2 * nbar); ++nbar; } } while (0)
    const int lo = args.ph_lo, hi = args.ph_hi;
#ifndef PH_MASK
#define PH_MASK 0xFFF
#endif
#define IN(k) ((((PH_MASK) >> (k)) & 1) && lo <= (k) && (k) < hi)
#define BOTH(k) (IN(k) && IN((k) + 1))
#ifndef REP_MASK
#define REP_MASK 0
#endif
#ifndef REP_N
#define REP_N 3
#endif
#define REPF(k) for (int rep_ = 0; rep_ < 1 + ((((REP_MASK) >> (k)) & 1) ? (REP_N) : 0); ++rep_)
#define OPAQUE() do { int t_ = threadIdx.x; asm volatile("" : "+v"(t_)); F.tid = t_; F.lane = t_ & 63; } while (0)
    const int gw = F.vcu * NWAVES + F.wave, NGW = F.G * NWAVES;

    if (IN(0)) { OPAQUE(); } if (IN(0)) REPF(0) { F.x = fin(F, 0); F.ln1_g = fin(F, 1); F.w_in = fin(F, 2); F.w_bsb = fin(F, 3); F.w_bhg = fin(F, 4); F.w_out = fin(F, 7); F.w_eg = fin(F, 13); F.w_eu = fin(F, 14); F.w_ed = fin(F, 15); p0_prologue(F); if (BOTH(0)) GRID_BAR(); }

    if (IN(1)) REPF(1) {
        F.lbl = fin(F, 6); F.w_eg = fin(F, 13); F.w_eu = fin(F, 14); F.w_ed = fin(F, 15); F.w_in = fin(F, 2); F.w_bsb = fin(F, 3); F.w_bhg = fin(F, 4); F.w_out = fin(F, 7);
        pg8::Gemm g{(const bf16*)(ws + WS_XN), (const bf16*)(ws + WS_WIN), M, IN_COLS, D}; pg8::StaticOrder S; S.init(M, IN_COLS, F.G, (int)blockIdx.x);
        pg8::EpiProj E{(bf16*)(ws + WS_QS), (bf16*)(ws + WS_KS), (bf16*)(ws + WS_VS), (bf16*)(ws + WS_QH), (bf16*)(ws + WS_KH), (bf16*)(ws + WS_VH), (bf16*)(ws + WS_GH),
                       (bf16*)F.out, (bf16*)F.out + (size_t)M * D, (float*)(ws + WS_LOGF), (float*)(ws + WS_SMALL + SM_EMID), (float*)(ws + WS_SMALL + SM_ELM), (float*)(ws + WS_SMALL + SM_DEC), F.lbl};
        pg8::gemm_phase<pg8::EpiProj, pg8::StaticOrder, PG8_ALIGN, PG8_SP2>(F.lds, g, S, E);
        {
            const int nfull = S.nwg % F.G, c = (int)blockIdx.x; const int nshort = nfull ? F.G - nfull : F.G, idx = nfull ? c - nfull : c;
            if (idx >= 0) { OPAQUE(); LAS float* scr = (LAS float*)(F.lds + F.wave * 16384);
                convert_range(F, idx * NWAVES + F.wave, N_LATE, nshort * NWAVES, N_EARLY, scr); }
        }
        if (BOTH(1)) GRID_BAR();
    }

    if (IN(2)) { OPAQUE(); } if (IN(2)) REPF(2) {
        for (int u = gw; u < 2048; u += NGW) hg_local_mfma(F, u);
        if (BOTH(2)) GRID_BAR();
    }

    if (IN(3)) { OPAQUE(); } if (IN(3)) {
        LAS int* aq = (LAS int*)(F.lds + LDSCTL_OFF + 256);
        if (F.tid == 0) aq[0] = 0;
        __syncthreads();
        for (int blk = F.vcu; blk < 256; blk += F.G) hg_scan(F, blk);
        for (;;) { int u = 0; if (F.lane == 0) u = __hip_atomic_fetch_add(aq, 1, __ATOMIC_RELAXED, __HIP_MEMORY_SCOPE_WORKGROUP);
            u = __builtin_amdgcn_readfirstlane(u); const int unit = F.vcu + u * F.G; if (unit >= 4096) break;
            sb_attn_unit_mfma(F, unit, (bf16*)(ws + WS_QS)); }
        if (BOTH(3)) GRID_BAR(); }

    if (IN(4)) { OPAQUE(); } if (IN(4)) REPF(4) { F.hg_norm_g = fin(F, 5); for (int u = gw; u < 2048; u += NGW) hg_out_mfma(F, u); if (BOTH(4)) GRID_BAR(); }

    if (IN(5)) REPF(5) {
        pg8::Gemm g{(const bf16*)(ws + WS_QS), (const bf16*)(ws + WS_WBR), 2 * M, 2048, HW}; pg8::BranchOrder S; S.S.init(M, D, F.G, (int)blockIdx.x);
        pg8::EpiBranch E{(const bf16*)F.out, (const bf16*)F.out + (size_t)M * D, (bf16*)(ws + WS_XN)};
        for (int r = 0; r * F.G < 256; ++r) { S.S.c = (int)blockIdx.x + r * F.G; pg8::gemm_phase<pg8::EpiBranch, pg8::BranchOrder, false, PG8_SP2>(F.lds, g, S, E); }
        if (BOTH(5)) GRID_BAR();
    }

    if (IN(6)) REPF(6) {
        pg8::Gemm g{(const bf16*)(ws + WS_XN), (const bf16*)(ws + WS_WOUT), M, D, D}; pg8::StaticOrder S; S.init(M, D, F.G, (int)blockIdx.x);
        pg8::EpiResBf16 E{fin(F, 0), (bf16*)(ws + WS_X1)};
        pg8::gemm_phase<pg8::EpiResBf16, pg8::StaticOrder, PG8_ALIGN, PG8_SP2>(F.lds, g, S, E);
        if (BOTH(6)) GRID_BAR();
    }

    if (IN(7)) { OPAQUE(); } if (IN(7)) REPF(7) { F.ln2_g = fin(F, 8); F.w_rg = fin(F, 9); F.b_rg = fin(F, 10); F.w_re = fin(F, 11); F.b_re = fin(F, 12); router_phase(F); if (BOTH(7)) GRID_BAR(); }

    if (IN(8)) { OPAQUE(); } if (IN(8)) REPF(8) { F.ln2_g = fin(F, 8); sort_gather_phase(F); touch_expert_weights(F); if (BOTH(8)) GRID_BAR(); }

    if (IN(9) || IN(10)) {
        LAS int* tp = (LAS int*)(F.lds + LDSCTL_OFF);
        if (F.tid <= 16) tp[F.tid] = ((const int*)(ws + WS_SMALL + SM_META))[F.tid];
        __syncthreads();
    }
    if (IN(9)) REPF(9) {
        const LAS int* tp = (const LAS int*)(F.lds + LDSCTL_OFF);
        pg8::Gemm g{(const bf16*)(ws + WS_TS), (const bf16*)(ws + WS_W1), MOE_ROWS, NEXP * 1024, D}; pg8::MoeOrder S{tp[16] * 4, F.G, (int)blockIdx.x, tp};
        pg8::EpiMoeUp E{(bf16*)(ws + WS_H)};
        pg8::gemm_phase<pg8::EpiMoeUp, pg8::MoeOrder, PG8_ALIGN, true, true>(F.lds, g, S, E, (const int*)(ws + WS_SMALL + SM_ROWTOK));
        if (BOTH(9)) GRID_BAR();
    }
    if (IN(10)) REPF(10) {
        const LAS int* tp = (const LAS int*)(F.lds + LDSCTL_OFF);
        pg8::Gemm g{(const bf16*)(ws + WS_H), (const bf16*)(ws + WS_WD), MOE_ROWS, NEXP * 1024, DEXP}; pg8::MoeOrder S{tp[16] * 4, F.G, (int)blockIdx.x, tp};
        pg8::EpiMoeDown E{(const int*)(ws + WS_SMALL + SM_ROWTOK), (const float*)(ws + WS_SMALL + SM_ROWW), (bf16*)(ws + WS_XN), (bf16*)(ws + WS_Y1)};
        pg8::gemm_phase<pg8::EpiMoeDown, pg8::MoeOrder, PG8_ALIGN, PG8_SP2>(F.lds, g, S, E);
        if (BOTH(10)) GRID_BAR();
    }

    if (IN(11)) { OPAQUE(); } if (IN(11)) { F.final_g = fin(F, 16); final_phase(F); }
#ifdef PROBE_A0
    {
        asm volatile("s_waitcnt vmcnt(0)" ::: "memory"); __syncthreads(); TS_MARK(23);
        if ((int)blockIdx.x == (PROBE_BLK) && threadIdx.x == 0) { volatile LAS unsigned long long* T = (volatile LAS unsigned long long*)(F.lds + LDSCTL_OFF + 1024);
            const unsigned long long dA = T[PROBE_A1] - T[PROBE_A0], dB = T[PROBE_B1] - T[PROBE_B0];
            const unsigned long long extra = dA * (PROBE_WA) + ((dB + 50ull) / 100ull) * (100ull * (PROBE_QB));
            const unsigned long long t0 = __builtin_amdgcn_s_memrealtime();
            while (__builtin_amdgcn_s_memrealtime() - t0 < extra) __builtin_amdgcn_s_sleep(8); }
    }
#endif
#undef IN
#undef BOTH
#undef GRID_BAR
}

extern "C" void kernel_launch(void* const* d_in, const int* in_sizes, int n_in, void* d_out, int out_size, void* d_ws, size_t ws_size, hipStream_t stream) {
    static int grid = 0;
    if (grid == 0) {
        if (n_in != 17 || in_sizes[0] != M * D || out_size != M * D || ws_size < WS_END) { fprintf(stderr, "kernel_launch: unexpected shapes (n_in %d, in0 %d, out %d, ws %zu); nothing launched\n", n_in, n_in > 0 ? in_sizes[0] : -1, out_size, ws_size); grid = -1; return; }
        int dev = 0, cus = 0, per_cu = 0;
        if (hipGetDevice(&dev) != hipSuccess || hipDeviceGetAttribute(&cus, hipDeviceAttributeMultiprocessorCount, dev) != hipSuccess) { grid = -1; return; }
        if (hipFuncSetAttribute((const void*)hybrid_fwd, hipFuncAttributeMaxDynamicSharedMemorySize, LDS_BYTES) != hipSuccess) { fprintf(stderr, "kernel_launch: hipFuncSetAttribute failed\n"); grid = -1; return; }
        if (hipOccupancyMaxActiveBlocksPerMultiprocessor(&per_cu, (const void*)hybrid_fwd, NWAVES * 64, LDS_BYTES) != hipSuccess || per_cu < 1)
            fprintf(stderr, "kernel_launch: note: occupancy query reports %d workgroups per CU\n", per_cu);
        (void)hipGetLastError();
        grid = cus;
    }
    if (grid < 0) return;
    if (hipMemsetAsync((char*)d_ws + WS_CTL, 0, CTL_ZERO_BYTES, stream) != hipSuccess) return;
    Args a{};
    for (int i = 0; i < 17; ++i) a.in[i] = (const float*)d_in[i];
    a.out = (float*)d_out; a.ws = (unsigned char*)d_ws;
    if (N_LAUNCHES == 1) {
        a.ph_lo = 0; a.ph_hi = N_PHASES; a.li = 0;
        hipLaunchKernelGGL(hybrid_fwd, dim3(grid), dim3(NWAVES * 64), LDS_BYTES, stream, a);
    } else {
        for (int li = 0; li < N_PHASES; ++li) { a.ph_lo = li; a.ph_hi = li + 1; a.li = li; hipLaunchKernelGGL(hybrid_fwd, dim3(grid), dim3(NWAVES * 64), LDS_BYTES, stream, a); }
    }
}
```

```cpp
#include <hip/hip_runtime.h>
#include <cstdio>
#include <cstdint>

#ifndef MK_N_LAUNCHES
#define MK_N_LAUNCHES 1
#endif

namespace pg8 {
#define PG8_LAS __attribute__((address_space(3)))
typedef unsigned short bf16_t;
typedef short bf16x8 __attribute__((ext_vector_type(8)));
typedef float f32x4 __attribute__((ext_vector_type(4)));
typedef unsigned u32x4 __attribute__((ext_vector_type(4)));
constexpr int BM = 256, BK = 64, HALF = 128, HTB = HALF * BK * 2  , STAGE_BYTES = 8 * HTB, NXCD = 8, WGM = 8;

__host__ __device__ __forceinline__ int lds_byte(int r, int c) { const int st = (r >> 4) * 2 + (c >> 5), rr = r & 15, cc = c & 31, ob = rr * 64 + cc * 2; return st * 1024 + (ob ^ (((ob >> 9) & 1) << 5)); }
__host__ __device__ __forceinline__ void stage_rc(int b, int& R, int& C) { const int st = b / 1024, sb = b % 1024, swz = sb ^ (((sb >> 9) & 1) << 5); R = (st >> 1) * 16 + swz / 64; C = (st & 1) * 32 + (swz % 64) / 2; }
__host__ __device__ __forceinline__ int perm32(int rho) { const int n = rho >> 4, i = rho & 15; return 8 * (i >> 2) + 4 * n + (i & 3); }

struct Unit { int pm, pn; };
struct Gemm { const bf16_t* A; const bf16_t* Bt; int M, N, K; };

__host__ __device__ __forceinline__ int xcd_remap(int wgid, int nwg) { const int q = nwg / NXCD, r = nwg % NXCD, xcd = wgid % NXCD, off = wgid / NXCD; return (xcd < r ? xcd * (q + 1) : r * (q + 1) + (xcd - r) * q) + off; }

struct StaticOrder {
    int nM, nN, nwg, G, c;
    __host__ __device__ void init(int M, int N, int G_, int c_) { nM = M / BM; nN = N / BM; nwg = nM * nN; G = G_; c = c_; }
    __host__ __device__ bool next(int i, Unit& u) const {
        const long L = (long)i * G + c; if (L >= nwg) return false;
        const int wgid = xcd_remap((int)L, nwg);
        const int nig = WGM * nN, gid = wgid / nig, fm = gid * WGM, gsz = (nM - fm) < WGM ? (nM - fm) : WGM;
        u.pm = fm + ((wgid % nig) % gsz); u.pn = (wgid % nig) / gsz; return true;
    }
};
struct BranchOrder {
    StaticOrder S;
    __device__ bool next(int i, Unit& u) const { if (i >= 2) return false; if (!S.next(0, u)) return false; if (i == 1) { u.pm += 64; u.pn += 4; } return true; }
};
struct MoeOrder {
    int nwg, G, c; const PG8_LAS int* tp;
    __device__ bool next(int i, Unit& u) const {
        const long L = (long)i * G + c; if (L >= nwg) return false;
        const int wgid = xcd_remap((int)L, nwg); const int mt = wgid >> 2, nt = wgid & 3; int e = 0;
#pragma unroll
        for (int j = 1; j < 16; ++j) e += (mt >= tp[j]) ? 1 : 0;
        u.pm = mt; u.pn = e * 4 + nt; return true;
    }
};

__device__ __forceinline__ unsigned cvt_pk_bf16(float lo, float hi) { typedef float f2_ __attribute__((ext_vector_type(2))); typedef __bf16 b2_ __attribute__((ext_vector_type(2))); f2_ v = {lo, hi}; return __builtin_bit_cast(unsigned, __builtin_convertvector(v, b2_)); }
__device__ __forceinline__ float bf_lo(unsigned u) { return __uint_as_float(u << 16); }
__device__ __forceinline__ float bf_hi(unsigned u) { return __uint_as_float(u & 0xffff0000u); }
template <int CTRL> __device__ __forceinline__ float dpp_f(float v) { return __builtin_bit_cast(float, __builtin_amdgcn_update_dpp(0, __builtin_bit_cast(int, v), CTRL, 0xF, 0xF, true)); }
__device__ __forceinline__ float sigmoidf_(float x) { return __builtin_amdgcn_rcpf(1.0f + __expf(-x)); }


struct EpiProj {
    static constexpr bool PERM = true, AFTER_DRAIN = false;
    bf16_t *Qs, *Ks, *Vs, *Qh, *Kh, *Vh, *Gh, *gsb, *ghg; float* logf; float *emid, *elm, *dec; const float* lbl;
    __device__ __forceinline__ bool keep(const Unit&) const { return false; }
    __device__ __forceinline__ void operator()(f32x4 (&acc)[2][2][4][2], const Unit& u, int wr, int wc, int fr, int fq) const {
        const int colt = u.pn * BM, grp = colt >> 9;
        const int row0 = u.pm * BM + wr * 64 + fr;
        int act = 0, pitch = 512, cb = (colt & 511) + wc * 32 + 8 * fq; bf16_t* dst = Qs;
        if (grp == 1) dst = Ks; else if (grp == 2) dst = Vs; else if (grp == 3) { dst = Qh; act = 1; } else if (grp == 4) { dst = Kh; act = 3; } else if (grp == 5) dst = Vh;
        else if (grp == 6) { dst = Gh; act = 1; } else if (grp == 7 || grp == 8) { dst = gsb; act = 2; pitch = 1024; cb = (colt - 3584) + wc * 32 + 8 * fq; }
        else if (grp >= 9) { dst = ghg; act = 2; pitch = 1024; cb = (colt - 4608) + wc * 32 + 8 * fq; }
        if (act == 2) {
            const int gc = ((colt - 3584) >> 8) * 128 + wc * 32 + 8 * fq;
#pragma unroll
            for (int ai = 0; ai < 2; ++ai)
#pragma unroll
                for (int m = 0; m < 4; ++m) { const size_t off = (size_t)(row0 + ai * HALF + m * 16) * 1024 + gc; float rr[8], ss[8];
#pragma unroll
                    for (int j = 0; j < 8; ++j) { const float a = sigmoidf_(acc[ai][0][m][j >> 2][j & 3]), b = fmaxf(sigmoidf_(acc[ai][1][m][j >> 2][j & 3]), 1e-30f); ss[j] = b; rr[j] = a * __builtin_amdgcn_rcpf(b); }
                    u32x4 w; w.x = cvt_pk_bf16(rr[0], rr[1]); w.y = cvt_pk_bf16(rr[2], rr[3]); w.z = cvt_pk_bf16(rr[4], rr[5]); w.w = cvt_pk_bf16(rr[6], rr[7]);
                    *(u32x4*)(gsb + off) = w;
                    u32x4 w2; w2.x = cvt_pk_bf16(ss[0], ss[1]); w2.y = cvt_pk_bf16(ss[2], ss[3]); w2.z = cvt_pk_bf16(ss[4], ss[5]); w2.w = cvt_pk_bf16(ss[6], ss[7]);
                    *(u32x4*)(ghg + off) = w2; }
            return;
        }
        float lb[2][8];
        if (act == 3) {
#pragma unroll
            for (int bj = 0; bj < 2; ++bj)
#pragma unroll
                for (int j = 0; j < 8; ++j) { const int c = cb + bj * HALF + j; lb[bj][j] = __builtin_amdgcn_rcpf(1.0f + __expf(lbl[512 + c] - lbl[c])); }
        }
#pragma unroll
        for (int ai = 0; ai < 2; ++ai)
#pragma unroll
            for (int m = 0; m < 4; ++m) { const size_t row = (size_t)(row0 + ai * HALF + m * 16);
#pragma unroll
                for (int bj = 0; bj < 2; ++bj) {
                    float v[8]; { const f32x4 a = acc[ai][bj][m][0], b = acc[ai][bj][m][1]; v[0] = a[0]; v[1] = a[1]; v[2] = a[2]; v[3] = a[3]; v[4] = b[0]; v[5] = b[1]; v[6] = b[2]; v[7] = b[3]; }
                    if (act == 1) {
#pragma unroll
                        for (int j = 0; j < 8; ++j) v[j] = v[j] * sigmoidf_(v[j]);
                    } else if (act == 3) {
#pragma unroll
                        for (int j = 0; j < 8; ++j) { const float l = lb[bj][j], sg = sigmoidf_(v[j]); const float f = l + (1.0f - l) * sg; const float lg = __logf(f); v[j] = 1.0f - f;
                            acc[ai][bj][m][j >> 2][j & 3] = lg; }
                    }
                    u32x4 w; w.x = cvt_pk_bf16(v[0], v[1]); w.y = cvt_pk_bf16(v[2], v[3]); w.z = cvt_pk_bf16(v[4], v[5]); w.w = cvt_pk_bf16(v[6], v[7]);
                    *(u32x4*)(dst + row * pitch + cb + bj * HALF) = w;
                } }
        if (act == 3) {
#pragma unroll
            for (int ai = 0; ai < 2; ++ai)
#pragma unroll
                for (int bj = 0; bj < 2; ++bj) { float mid[8], last[8];
#pragma unroll
                    for (int j = 0; j < 8; ++j) { float carry = 0.f;
#pragma unroll
                        for (int m = 0; m < 4; ++m) { float x = acc[ai][bj][m][j >> 2][j & 3];
                            x += dpp_f<0x111>(x); x += dpp_f<0x112>(x); x += dpp_f<0x114>(x); x += dpp_f<0x118>(x);
                            x += carry; acc[ai][bj][m][j >> 2][j & 3] = x; carry = dpp_f<0x15F>(x); if (m == 1) mid[j] = carry; }
                        last[j] = carry; }
#pragma unroll
                    for (int m = 0; m < 4; ++m) { bf16_t* kq = Kh + (size_t)(row0 + ai * HALF + m * 16) * 512 + cb + bj * HALF;
                        const u32x4 kw = *(const u32x4*)kq; float bb[8] = {bf_lo(kw.x), bf_hi(kw.x), bf_lo(kw.y), bf_hi(kw.y), bf_lo(kw.z), bf_hi(kw.z), bf_lo(kw.w), bf_hi(kw.w)};
#pragma unroll
                        for (int j = 0; j < 8; ++j) bb[j] *= __expf(mid[j] - acc[ai][bj][m][j >> 2][j & 3]);
                        u32x4 w; w.x = cvt_pk_bf16(bb[0], bb[1]); w.y = cvt_pk_bf16(bb[2], bb[3]); w.z = cvt_pk_bf16(bb[4], bb[5]); w.w = cvt_pk_bf16(bb[6], bb[7]);
                        *(u32x4*)kq = w;
                        float ea[8];
#pragma unroll
                        for (int j = 0; j < 8; ++j) ea[j] = __expf(acc[ai][bj][m][j >> 2][j & 3] - mid[j]);
                        u32x4 w2; w2.x = cvt_pk_bf16(ea[0], ea[1]); w2.y = cvt_pk_bf16(ea[2], ea[3]); w2.z = cvt_pk_bf16(ea[4], ea[5]); w2.w = cvt_pk_bf16(ea[6], ea[7]);
                        *(u32x4*)((bf16_t*)logf + (size_t)(row0 + ai * HALF + m * 16) * 512 + cb + bj * HALF) = w2; }
                    if (fr == 15) { const size_t vo = (size_t)(4 * u.pm + 2 * ai + wr) * 512 + cb + bj * HALF;
                        *(f32x4*)(emid + vo) = (f32x4){__expf(mid[0]), __expf(mid[1]), __expf(mid[2]), __expf(mid[3])}; *(f32x4*)(emid + vo + 4) = (f32x4){__expf(mid[4]), __expf(mid[5]), __expf(mid[6]), __expf(mid[7])};
                        *(f32x4*)(elm + vo) = (f32x4){__expf(last[0] - mid[0]), __expf(last[1] - mid[1]), __expf(last[2] - mid[2]), __expf(last[3] - mid[3])};
                        *(f32x4*)(elm + vo + 4) = (f32x4){__expf(last[4] - mid[4]), __expf(last[5] - mid[5]), __expf(last[6] - mid[6]), __expf(last[7] - mid[7])};
                        *(f32x4*)(dec + vo) = (f32x4){__expf(last[0]), __expf(last[1]), __expf(last[2]), __expf(last[3])}; *(f32x4*)(dec + vo + 4) = (f32x4){__expf(last[4]), __expf(last[5]), __expf(last[6]), __expf(last[7])}; } }
        }
    }
};

struct EpiBranch {
    static constexpr bool PERM = true, AFTER_DRAIN = false;
    const bf16_t *gsb, *ghg; bf16_t* out;
    __device__ __forceinline__ bool keep(const Unit& u) const { return u.pn < 4; }
    __device__ __forceinline__ void operator()(f32x4 (&acc)[2][2][4][2], const Unit& u, int wr, int wc, int fr, int fq) const {
        const bool first = u.pn < 4; const int pn = u.pn & 3, pm = u.pm & 63;
        const int row0 = pm * BM + wr * 64 + fr, col0 = pn * BM + wc * 32 + 8 * fq;
        const bf16_t* gp = first ? gsb : ghg;
#pragma unroll
        for (int ai = 0; ai < 2; ++ai)
#pragma unroll
            for (int m = 0; m < 4; ++m) { const size_t off = (size_t)(row0 + ai * HALF + m * 16) * 1024 + col0;
#pragma unroll
                for (int bj = 0; bj < 2; ++bj) {
                    const u32x4 gh = *(const u32x4*)(gp + off + bj * HALF);
                    const float s[8] = {bf_lo(gh.x), bf_hi(gh.x), bf_lo(gh.y), bf_hi(gh.y), bf_lo(gh.z), bf_hi(gh.z), bf_lo(gh.w), bf_hi(gh.w)};
                    f32x4 a = acc[ai][bj][m][0], b = acc[ai][bj][m][1];
                    a[0] *= s[0]; a[1] *= s[1]; a[2] *= s[2]; a[3] *= s[3]; b[0] *= s[4]; b[1] *= s[5]; b[2] *= s[6]; b[3] *= s[7];
                    acc[ai][bj][m][0] = a; acc[ai][bj][m][1] = b;
                    if (!first) { u32x4 w; w.x = cvt_pk_bf16(a[0], a[1]); w.y = cvt_pk_bf16(a[2], a[3]); w.z = cvt_pk_bf16(b[0], b[1]); w.w = cvt_pk_bf16(b[2], b[3]);
                        *(u32x4*)(out + off + bj * HALF) = w; }
                } }
    }
};

struct EpiResBf16 {
    static constexpr bool PERM = true, AFTER_DRAIN = false;
    const float* base; bf16_t* out;
    __device__ __forceinline__ bool keep(const Unit&) const { return false; }
    __device__ __forceinline__ void operator()(f32x4 (&acc)[2][2][4][2], const Unit& u, int wr, int wc, int fr, int fq) const {
        const int row0 = u.pm * BM + wr * 64 + fr, col0 = u.pn * BM + wc * 32 + 8 * fq;
#pragma unroll
        for (int ai = 0; ai < 2; ++ai)
#pragma unroll
            for (int m = 0; m < 4; ++m) { const size_t off = (size_t)(row0 + ai * HALF + m * 16) * 1024 + col0;
#pragma unroll
                for (int bj = 0; bj < 2; ++bj) { const f32x4 x0 = *(const f32x4*)(base + off + bj * HALF) + acc[ai][bj][m][0], x1 = *(const f32x4*)(base + off + bj * HALF + 4) + acc[ai][bj][m][1];
                    u32x4 w; w.x = cvt_pk_bf16(x0[0], x0[1]); w.y = cvt_pk_bf16(x0[2], x0[3]); w.z = cvt_pk_bf16(x1[0], x1[1]); w.w = cvt_pk_bf16(x1[2], x1[3]);
                    *(u32x4*)(out + off + bj * HALF) = w; } }
    }
};

struct EpiMoeUp {
    static constexpr bool PERM = true, AFTER_DRAIN = false;
    bf16_t* H;
    __device__ __forceinline__ bool keep(const Unit&) const { return false; }
    __device__ __forceinline__ void operator()(f32x4 (&acc)[2][2][4][2], const Unit& u, int wr, int wc, int fr, int fq) const {
        const int nt = u.pn & 3; const int row0 = u.pm * BM + wr * 64 + fr, col0 = nt * 128 + wc * 32 + 8 * fq;
#pragma unroll
        for (int ai = 0; ai < 2; ++ai)
#pragma unroll
            for (int m = 0; m < 4; ++m) { const size_t off = (size_t)(row0 + ai * HALF + m * 16) * 512 + col0;
                float v[8];
#pragma unroll
                for (int n = 0; n < 2; ++n)
#pragma unroll
                    for (int j = 0; j < 4; ++j) { const float g = acc[ai][0][m][n][j], up = acc[ai][1][m][n][j]; v[n * 4 + j] = g * sigmoidf_(g) * up; }
                u32x4 w; w.x = cvt_pk_bf16(v[0], v[1]); w.y = cvt_pk_bf16(v[2], v[3]); w.z = cvt_pk_bf16(v[4], v[5]); w.w = cvt_pk_bf16(v[6], v[7]);
                *(u32x4*)(H + off) = w; }
    }
};

struct EpiMoeDown {
    static constexpr bool PERM = true, AFTER_DRAIN = false;
    const int* rowtok; const float* roww; bf16_t* Y0; bf16_t* Y1;
    __device__ __forceinline__ bool keep(const Unit&) const { return false; }
    __device__ __forceinline__ void operator()(f32x4 (&acc)[2][2][4][2], const Unit& u, int wr, int wc, int fr, int fq) const {
        const int nt = u.pn & 3; const int row0 = u.pm * BM + wr * 64 + fr, col0 = nt * BM + wc * 32 + 8 * fq;
#pragma unroll
        for (int ai = 0; ai < 2; ++ai)
#pragma unroll
            for (int m = 0; m < 4; ++m) { const int prow = row0 + ai * HALF + m * 16; const int ts = rowtok[prow]; const float w = roww[prow];
                if (ts >= 0) { bf16_t* yp = ((ts & 1) ? Y1 : Y0) + (size_t)(ts >> 1) * 1024 + col0;
#pragma unroll
                    for (int bj = 0; bj < 2; ++bj) { const f32x4 a = acc[ai][bj][m][0] * w, b = acc[ai][bj][m][1] * w;
                        u32x4 o; o.x = cvt_pk_bf16(a[0], a[1]); o.y = cvt_pk_bf16(a[2], a[3]); o.z = cvt_pk_bf16(b[0], b[1]); o.w = cvt_pk_bf16(b[2], b[3]);
                        *(u32x4*)(yp + bj * HALF) = o; } } }
    }
};

template <class Epi, class Sched, bool ALIGN_EPI = false, bool SP2 = false, bool GATHER = false>
__device__ __forceinline__ void gemm_phase(PG8_LAS unsigned char* lds, const Gemm g, const Sched& S, const Epi& E, const int* rowidx = nullptr) {
    static_assert(!GATHER || SP2, "GATHER is implemented for the SP2 loop");
    int tid_ = threadIdx.x; asm volatile("" : "+v"(tid_));
    const int tid = tid_, wid = __builtin_amdgcn_readfirstlane(tid >> 6), lane = tid & 63, wr = wid >> 2, wc = wid & 3, fr = lane & 15, fq = lane >> 4;
    const int K = g.K, nt = K / BK;
    unsigned voffA[2], voffB[2]; int rslot[2] = {0, 0}; unsigned coff[2] = {0u, 0u};
#pragma unroll
    for (int i = 0; i < 2; ++i) { int R, C; stage_rc(tid * 16 + i * 8192, R, C); const int Rb = Epi::PERM ? ((R & ~31) + perm32(R & 31)) : R;
        voffA[i] = (unsigned)(R * K + C) * 2u; voffB[i] = (unsigned)(Rb * K + C) * 2u; if constexpr (GATHER) { rslot[i] = R; coff[i] = (unsigned)C * 2u; } }
    const size_t kstep = (size_t)(BK * 2);
    const size_t hstep = (size_t)HALF * K * 2;
    const size_t tstep = 2 * hstep;
    const unsigned ldsw = (unsigned)wid * 1024u;
    const int aoff = lds_byte(wr * 64 + fr, fq * 8), boff = lds_byte(wc * 32 + fr, fq * 8);
#define PG8_SA(b, h) (((b) * 2 + (h)) * HTB)
#define PG8_SB(b, h) ((4 + (b) * 2 + (h)) * HTB)
#define PG8_STAGE(bufoff, gbase, voff) do { _Pragma("unroll") for (int _i = 0; _i < 2; ++_i) \
        __builtin_amdgcn_global_load_lds((const unsigned*)((const char*)(gbase) + (voff)[_i]), (PG8_LAS unsigned*)(lds + (bufoff) + ldsw + _i * 8192), 16, 0, 0); } while (0)
#define PG8_LDA(dst, b, h) do { _Pragma("unroll") for (int m = 0; m < 4; ++m) _Pragma("unroll") for (int k = 0; k < 2; ++k) dst[m][k] = *(const PG8_LAS bf16x8*)(lds + PG8_SA(b, h) + aoff + m * 2048 + k * 1024); } while (0)
#define PG8_LDB(dst, b, h) do { _Pragma("unroll") for (int n = 0; n < 2; ++n) _Pragma("unroll") for (int k = 0; k < 2; ++k) dst[n][k] = *(const PG8_LAS bf16x8*)(lds + PG8_SB(b, h) + boff + n * 2048 + k * 1024); } while (0)
#define PG8_MMA(ai, bj, At, Bt) do { __builtin_amdgcn_s_setprio(1); _Pragma("unroll") for (int m = 0; m < 4; ++m) _Pragma("unroll") for (int n = 0; n < 2; ++n) _Pragma("unroll") for (int k = 0; k < 2; ++k) \
        acc[ai][bj][m][n] = __builtin_amdgcn_mfma_f32_16x16x32_bf16(Bt[n][k], At[m][k], acc[ai][bj][m][n], 0, 0, 0); __builtin_amdgcn_s_setprio(0); } while (0)
#define PG8_WAIT_V(n) asm volatile("s_waitcnt vmcnt(" #n ")" ::: "memory")
#define PG8_WAIT_L(n) asm volatile("s_waitcnt lgkmcnt(" #n ")" ::: "memory")
#define PG8_BAR __builtin_amdgcn_s_barrier()
#define PG8_SCHED __builtin_amdgcn_sched_barrier(0)
    Unit cur, nxt; int ui = 0;
    if (!S.next(0, cur)) return;
    f32x4 acc[2][2][4][2];
#pragma unroll
    for (int a = 0; a < 2; ++a)
#pragma unroll
        for (int b = 0; b < 2; ++b)
#pragma unroll
            for (int m = 0; m < 4; ++m)
#pragma unroll
                for (int n = 0; n < 2; ++n) acc[a][b][m][n] = (f32x4){0.f, 0.f, 0.f, 0.f};
    bf16x8 At[4][2], B0[2][2], B1[2][2];
    unsigned gC[2][2], gN[2][2];
#define PG8_ROWOFFS(dst, U) do { _Pragma("unroll") for (int h_ = 0; h_ < 2; ++h_) _Pragma("unroll") for (int i_ = 0; i_ < 2; ++i_) { \
        if constexpr (GATHER) { const int t_ = rowidx[(U).pm * BM + h_ * HALF + rslot[i_]]; dst[h_][i_] = (unsigned)((t_ < 0 ? 0 : (t_ >> 1)) * K) * 2u + coff[i_]; } \
        else dst[h_][i_] = voffA[i_] + (unsigned)(h_ * hstep); } } while (0)
    PG8_ROWOFFS(gC, cur);
#pragma unroll
    for (int h_ = 0; h_ < 2; ++h_)
#pragma unroll
        for (int i_ = 0; i_ < 2; ++i_) gN[h_][i_] = gC[h_][i_];
    const char* cA = (const char*)g.A + (GATHER ? (size_t)0 : (size_t)cur.pm * tstep); const char* cB = (const char*)g.Bt + (size_t)cur.pn * tstep;
    if constexpr (SP2) {
        PG8_STAGE(PG8_SB(0, 0), cB, voffB); PG8_STAGE(PG8_SB(0, 1), cB + hstep, voffB); PG8_STAGE(PG8_SA(0, 0), cA, gC[0]); PG8_STAGE(PG8_SA(0, 1), cA, gC[1]);
        if (wr == 1) PG8_BAR;
        PG8_WAIT_V(2); PG8_BAR;
        PG8_STAGE(PG8_SB(1, 0), cB + kstep, voffB); PG8_STAGE(PG8_SA(1, 0), cA + kstep, gC[0]); PG8_STAGE(PG8_SB(1, 1), cB + hstep + kstep, voffB);
        PG8_WAIT_V(6); PG8_BAR;
    } else {
        PG8_STAGE(PG8_SB(0, 0), cB, voffB); PG8_STAGE(PG8_SA(0, 0), cA, voffA); PG8_STAGE(PG8_SB(0, 1), cB + hstep, voffB); PG8_STAGE(PG8_SA(0, 1), cA + hstep, voffA);
        if (wr == 1) PG8_BAR;
        PG8_WAIT_V(4); PG8_BAR;
        PG8_STAGE(PG8_SB(1, 0), cB + kstep, voffB); PG8_STAGE(PG8_SA(1, 0), cA + kstep, voffA); PG8_STAGE(PG8_SB(1, 1), cB + hstep + kstep, voffB);
        PG8_WAIT_V(6); PG8_BAR;
    }
    for (;;) {
        const bool has_next = S.next(ui + 1, nxt);
        const char* nA = (has_next && !GATHER) ? (const char*)g.A + (size_t)nxt.pm * tstep : cA; const char* nB = has_next ? (const char*)g.Bt + (size_t)nxt.pn * tstep : cB;
        if (has_next) { PG8_ROWOFFS(gN, nxt); }
        for (int t = 0; t < nt; t += 2) {
            const bool last = (t == nt - 2);
            const char* a1 = cA + (size_t)(t + 1) * kstep;
            const char* a2 = last ? nA : cA + (size_t)(t + 2) * kstep; const char* b2 = last ? nB : cB + (size_t)(t + 2) * kstep;
            const char* a3 = a2 + kstep; const char* b3 = b2 + kstep;
            if constexpr (SP2) {
            unsigned g2[2][2];
#pragma unroll
            for (int h_ = 0; h_ < 2; ++h_)
#pragma unroll
                for (int i_ = 0; i_ < 2; ++i_) g2[h_][i_] = last ? gN[h_][i_] : gC[h_][i_];
            PG8_LDB(B0, 0, 0); PG8_LDB(B1, 0, 1); PG8_SCHED; PG8_LDA(At, 0, 0); PG8_STAGE(PG8_SA(1, 1), a1, gC[1]);
            PG8_WAIT_V(8); PG8_WAIT_L(0); PG8_BAR; PG8_MMA(0, 0, At, B0); PG8_MMA(0, 1, At, B1); PG8_BAR; PG8_SCHED;
            PG8_LDA(At, 0, 1); PG8_STAGE(PG8_SB(0, 0), b2, voffB); PG8_STAGE(PG8_SB(0, 1), b2 + hstep, voffB); PG8_STAGE(PG8_SA(0, 0), a2, g2[0]);
            PG8_WAIT_V(8); PG8_WAIT_L(0); PG8_BAR; PG8_MMA(1, 0, At, B0); PG8_MMA(1, 1, At, B1); PG8_BAR; PG8_SCHED;
            PG8_LDB(B0, 1, 0); PG8_LDB(B1, 1, 1); PG8_SCHED; PG8_LDA(At, 1, 0); PG8_STAGE(PG8_SA(0, 1), a2, g2[1]);
            PG8_WAIT_V(8); PG8_WAIT_L(0); PG8_BAR; PG8_MMA(0, 0, At, B0); PG8_MMA(0, 1, At, B1); PG8_BAR; PG8_SCHED;
            PG8_LDA(At, 1, 1); PG8_STAGE(PG8_SB(1, 0), b3, voffB); PG8_STAGE(PG8_SB(1, 1), b3 + hstep, voffB); PG8_STAGE(PG8_SA(1, 0), a3, g2[0]);
            PG8_WAIT_V(8); PG8_WAIT_L(0); PG8_BAR; PG8_MMA(1, 0, At, B0); PG8_MMA(1, 1, At, B1); PG8_BAR; PG8_SCHED;
            } else {
            PG8_LDB(B0, 0, 0); PG8_SCHED; PG8_LDA(At, 0, 0); PG8_STAGE(PG8_SA(1, 1), a1 + hstep, voffA);
            PG8_WAIT_L(8); PG8_BAR; PG8_WAIT_L(0); PG8_MMA(0, 0, At, B0); PG8_BAR; PG8_SCHED;
            PG8_LDB(B1, 0, 1); PG8_STAGE(PG8_SB(0, 0), b2, voffB);
            PG8_BAR; PG8_WAIT_L(0); PG8_MMA(0, 1, At, B1); PG8_BAR;
            PG8_LDA(At, 0, 1); PG8_STAGE(PG8_SA(0, 0), a2, voffA);
            PG8_BAR; PG8_WAIT_L(0); PG8_MMA(1, 0, At, B0); PG8_BAR; PG8_SCHED;
            PG8_STAGE(PG8_SB(0, 1), b2 + hstep, voffB);
            PG8_WAIT_V(6); PG8_BAR; PG8_MMA(1, 1, At, B1); PG8_BAR;
            PG8_LDB(B0, 1, 0); PG8_SCHED; PG8_LDA(At, 1, 0); PG8_STAGE(PG8_SA(0, 1), a2 + hstep, voffA);
            PG8_WAIT_L(8); PG8_BAR; PG8_WAIT_L(0); PG8_MMA(0, 0, At, B0); PG8_BAR; PG8_SCHED;
            PG8_LDB(B1, 1, 1); PG8_STAGE(PG8_SB(1, 0), b3, voffB);
            PG8_BAR; PG8_WAIT_L(0); PG8_MMA(0, 1, At, B1); PG8_BAR;
            PG8_LDA(At, 1, 1); PG8_STAGE(PG8_SA(1, 0), a3, voffA);
            PG8_BAR; PG8_WAIT_L(0); PG8_MMA(1, 0, At, B0); PG8_BAR; PG8_SCHED;
            PG8_STAGE(PG8_SB(1, 1), b3 + hstep, voffB);
            PG8_WAIT_V(6); PG8_BAR; PG8_MMA(1, 1, At, B1); PG8_BAR;
            }
        }
        if constexpr (ALIGN_EPI) { if (wr == 0) PG8_BAR; }
        E(acc, cur, wr, wc, fr, fq);
        if (!has_next) break;
        if (!E.keep(cur)) {
#pragma unroll
        for (int a = 0; a < 2; ++a)
#pragma unroll
            for (int b = 0; b < 2; ++b)
#pragma unroll
                for (int m = 0; m < 4; ++m)
#pragma unroll
                    for (int n = 0; n < 2; ++n) acc[a][b][m][n] = (f32x4){0.f, 0.f, 0.f, 0.f};
        }
        cur = nxt; cA = nA; cB = nB; ++ui;
#pragma unroll
        for (int h_ = 0; h_ < 2; ++h_)
#pragma unroll
            for (int i_ = 0; i_ < 2; ++i_) gC[h_][i_] = gN[h_][i_];
        if constexpr (ALIGN_EPI) { if (wr == 1) PG8_BAR; }
    }
    PG8_WAIT_V(0);
    if constexpr (!ALIGN_EPI) { if (wr == 0) PG8_BAR; }
    PG8_BAR;
#undef PG8_ROWOFFS
#undef PG8_SA
#undef PG8_SB
#undef PG8_STAGE
#undef PG8_LDA
#undef PG8_LDB
#undef PG8_MMA
#undef PG8_WAIT_V
#undef PG8_WAIT_L
#undef PG8_BAR
#undef PG8_SCHED
}
}

#ifndef PG8_SP2
#define PG8_SP2 true
#endif
#ifndef PG8_ALIGN
#define PG8_ALIGN true
#endif

constexpr int NWAVES = 8;
constexpr int N_LAUNCHES = MK_N_LAUNCHES;
constexpr int N_PHASES = 12;
constexpr int BATCH = 2, SEQ = 8192, D = 1024, M = BATCH * SEQ;
constexpr int HW = 512;
constexpr int IN_COLS = 5632, NEXP = 16, DEXP = 512;
constexpr float EPS = 1e-6f;
constexpr int MOE_ROWS = 36864;
constexpr float SB_EXIT = 30.0f;

constexpr size_t MiB = 1u << 20;
constexpr size_t WS_CTL = 0, CTL_ZERO_BYTES = 1 * MiB;
constexpr size_t WS_SMALL = 1 * MiB;
constexpr size_t WS_WIN = 4 * MiB;
constexpr size_t WS_WBR = 15 * MiB;
constexpr size_t WS_WOUT = 17 * MiB;
constexpr size_t WS_W1 = 19 * MiB;
constexpr size_t WS_WD = 51 * MiB;
constexpr size_t WS_XN = 67 * MiB;
constexpr size_t WS_QS = 99 * MiB;
constexpr size_t WS_KS = 115 * MiB, WS_VS = 131 * MiB, WS_QH = 147 * MiB, WS_KH = 163 * MiB, WS_VH = 179 * MiB;
constexpr size_t WS_SIN = 83 * MiB;
constexpr size_t WS_LOGF = 195 * MiB;
constexpr size_t WS_GH = 227 * MiB;
constexpr size_t WS_TS = 99 * MiB;
constexpr size_t WS_X1 = 131 * MiB;
constexpr size_t WS_H = 171 * MiB;
constexpr size_t WS_Y1 = 207 * MiB;
constexpr size_t WS_END = 256 * MiB;
static_assert(WS_GH + (size_t)M * HW * 2 <= WS_END && WS_Y1 + (size_t)M * D * 2 <= WS_END && WS_TS + (size_t)M * D * 2 <= WS_X1 && WS_X1 + (size_t)M * D * 2 <= WS_H && WS_H + (size_t)MOE_ROWS * DEXP * 2 <= WS_Y1, "ws map");
constexpr size_t SM_HIST = 0;
constexpr size_t SM_META = 16384;
constexpr size_t SM_TOKE = 32768;
constexpr size_t SM_TOKW = SM_TOKE + (size_t)M * 8;
constexpr size_t SM_RSTD = SM_TOKW + (size_t)M * 8;
constexpr size_t SM_ROWTOK = SM_RSTD + (size_t)M * 4;
constexpr size_t SM_ROWW = SM_ROWTOK + (size_t)MOE_ROWS * 4;
constexpr size_t SM_DEC = SM_ROWW + (size_t)MOE_ROWS * 4;
constexpr size_t SM_EMID = SM_DEC + 256 * 512 * 4, SM_ELM = SM_EMID + 256 * 512 * 4;
static_assert(WS_SMALL + SM_ELM + 256 * 512 * 4 <= WS_WIN, "small arrays");
constexpr int CW_BAR = 4096;

constexpr int RING_BYTES = 131072;
constexpr int LDSCTL_OFF = 143360, MISC_OFF = LDSCTL_OFF + 320;
constexpr int LDS_BYTES = 147456;

#define GAS __attribute__((address_space(1)))
#define LAS __attribute__((address_space(3)))
typedef unsigned short bf16;
typedef unsigned v4u __attribute__((ext_vector_type(4)));
typedef unsigned v2u __attribute__((ext_vector_type(2)));
typedef float f32x4 __attribute__((ext_vector_type(4)));
typedef GAS unsigned gu32;
#define RLX_AGENT __ATOMIC_RELAXED, __HIP_MEMORY_SCOPE_AGENT
#define LDS_WAIT() asm volatile("s_waitcnt lgkmcnt(0)" ::: "memory")
#define VM_WAIT() asm volatile("s_waitcnt vmcnt(0)" ::: "memory")
__device__ __forceinline__ unsigned f2bf(float f) { unsigned u = __builtin_bit_cast(unsigned, f); return (u + 0x7fffu + ((u >> 16) & 1u)) >> 16; }
__device__ __forceinline__ unsigned pk2(float lo, float hi) { return f2bf(lo) | (f2bf(hi) << 16); }
__device__ __forceinline__ float bf2f(bf16 v) { return __uint_as_float((unsigned)v << 16); }
__device__ __forceinline__ float blo(unsigned u) { return __uint_as_float(u << 16); }
__device__ __forceinline__ float bhi(unsigned u) { return __uint_as_float(u & 0xffff0000u); }

#define XB_TMO      128
#define XB_XCNT(j)  (256  + 64 * (j))
#define XB_XSUB(j)  (1280 + 64 * (j))
#define XB_XGEN(j)  (2304 + 64 * (j))
#define XB_TOP      3328
#define XB_TOPGEN   3392
#define XB_EXIT     3456
#define XCD_BAR_WORDS 3520
__device__ unsigned g_grid_barrier[XCD_BAR_WORDS];
#define XB_SPIN_CAP (1u << 18)
__device__ __forceinline__ unsigned xb_ld(unsigned* p)              { return __hip_atomic_load(p, __ATOMIC_RELAXED, __HIP_MEMORY_SCOPE_AGENT); }
__device__ __forceinline__ unsigned xb_add(unsigned* p, unsigned v) { return __hip_atomic_fetch_add(p, v, __ATOMIC_RELAXED, __HIP_MEMORY_SCOPE_AGENT); }
__device__ __forceinline__ unsigned xb_xcc_id() { return (unsigned)__builtin_amdgcn_s_getreg((3 << 11) | 20) & 0xFu; }
#define XB_SPIN(cond, bar) do { unsigned _sp = 0; while (cond) { __builtin_amdgcn_s_sleep(1); \
    if ((++_sp & 255u) == 0u) { if (xb_ld(&(bar)[XB_TMO])) break; if (_sp > XB_SPIN_CAP) { atomicAdd(&(bar)[XB_TMO], 1u); break; } } } } while (0)
struct XcdBarrier { unsigned* bar; unsigned x; volatile LAS unsigned* st; };
__device__ __forceinline__ XcdBarrier xcd_barrier_post(unsigned* bar, volatile LAS unsigned* st) {
    XcdBarrier b; b.bar = bar; b.x = xb_xcc_id(); b.st = st;
    if (threadIdx.x == 0) (void)xb_add(&bar[XB_XCNT(b.x)], 1u);
    return b;
}
__device__ __forceinline__ void xcd_barrier_complete(unsigned* bar, unsigned x, unsigned& nloc, unsigned& nx) {
    const unsigned G = gridDim.x * gridDim.y * gridDim.z;
    unsigned sum, cnt, mine, sp = 0u;
    for (;;) {
        sum = 0u; cnt = 0u; mine = 0u;
#pragma unroll
        for (unsigned j = 0; j < 16; ++j) { const unsigned c = xb_ld(&bar[XB_XCNT(j)]); sum += c; cnt += (c > 0u) ? 1u : 0u; mine = (j == x) ? c : mine; }
        if (sum == G) break;
        __builtin_amdgcn_s_sleep(1);
        if ((++sp & 255u) == 0u) { if (xb_ld(&bar[XB_TMO])) break; if (sp > XB_SPIN_CAP) { atomicAdd(&bar[XB_TMO], 1u); break; } }
    }
    nloc = mine > 0u ? mine : 1u; nx = cnt > 0u ? cnt : 1u;
}
__device__ __forceinline__ void xcd_barrier(const XcdBarrier& b) {
    asm volatile("s_waitcnt vmcnt(0)" ::: "memory");
    __syncthreads();
    if (threadIdx.x == 0) {
        unsigned* bar = b.bar;
        __builtin_amdgcn_s_waitcnt(0);
        unsigned nloc = b.st[0], nx = b.st[1];
        if (nloc == 0u) { xcd_barrier_complete(bar, b.x, nloc, nx); b.st[0] = nloc; b.st[1] = nx; }
        const unsigned old = xb_add(&bar[XB_XSUB(b.x)], 1u);
        const unsigned gen = old / nloc;
        if (old + 1u == (gen + 1u) * nloc) {
            __builtin_amdgcn_fence(__ATOMIC_RELEASE, "agent");
            asm volatile("s_waitcnt vmcnt(0)" ::: "memory");
            const unsigned og = xb_add(&bar[XB_TOP], 1u);
            const unsigned tg = og / nx;
            if (og + 1u == (tg + 1u) * nx) xb_add(&bar[XB_TOPGEN], 1u);
            else XB_SPIN(xb_ld(&bar[XB_TOPGEN]) == tg, bar);
            __builtin_amdgcn_fence(__ATOMIC_ACQUIRE, "agent");
            xb_add(&bar[XB_XGEN(b.x)], 1u);
            asm volatile("s_waitcnt vmcnt(0)" ::: "memory");
        } else {
            XB_SPIN(xb_ld(&bar[XB_XGEN(b.x)]) == gen, bar);
            __builtin_amdgcn_fence(__ATOMIC_ACQUIRE, "agent");
            asm volatile("s_waitcnt vmcnt(0)" ::: "memory");
        }
    }
    __syncthreads();
}

struct Frame {
    LAS unsigned char* lds;
    volatile LAS unsigned* MISC;
    gu32* ctl;
    int tid, lane, wave;
    int vcu, G;
    unsigned char* ws;
    const float* x; float* out;
    const float *ln1_g, *w_in, *w_bsb, *w_bhg, *hg_norm_g, *lbl, *w_out, *ln2_g, *w_rg, *b_rg, *w_re, *b_re, *w_eg, *w_eu, *w_ed, *final_g;
    volatile LAS unsigned long long* PT;
};
__device__ __forceinline__ const float* fin(const Frame& F, int k) { const unsigned long long v = F.PT[k]; const unsigned lo = __builtin_amdgcn_readfirstlane((unsigned)v), hi = __builtin_amdgcn_readfirstlane((unsigned)(v >> 32)); return (const float*)(const GAS float*)(((unsigned long long)hi << 32) | lo); }
__device__ __forceinline__ float wave_sum(float v) {
#pragma unroll
    for (int o = 1; o < 64; o <<= 1) v += __shfl_xor(v, o);
    return v;
}

struct CvItem { const float* src; bf16* dst; int N, K; };
__device__ __forceinline__ void cv_load(const CvItem& c, f32x4 (&v)[8], int lane) {
    const GAS float* p = (const GAS float*)c.src + (size_t)(lane >> 3) * c.N + (lane & 7) * 4;
#pragma unroll
    for (int i = 0; i < 8; ++i) v[i] = *(const GAS f32x4*)(p + (size_t)(8 * i) * c.N);
}
__device__ __forceinline__ void cv_finish(const CvItem& c, const f32x4 (&v)[8], LAS float* scr, int lane) {
#pragma unroll
    for (int i = 0; i < 8; ++i) { LAS float* d = scr + ((lane >> 3) + 8 * i) * 33 + (lane & 7) * 4; d[0] = v[i].x; d[1] = v[i].y; d[2] = v[i].z; d[3] = v[i].w; }
    LDS_WAIT(); asm volatile("" ::: "memory");
    const int cc = lane & 7;
#pragma unroll
    for (int j = 0; j < 4; ++j) { const int n = (lane >> 3) + 8 * j; const LAS float* s = scr + (8 * cc) * 33 + n;
        v4u o; o.x = pk2(s[0 * 33], s[1 * 33]); o.y = pk2(s[2 * 33], s[3 * 33]); o.z = pk2(s[4 * 33], s[5 * 33]); o.w = pk2(s[6 * 33], s[7 * 33]);
        *(GAS v4u*)(c.dst + (size_t)n * c.K + 8 * cc) = o; }
    LDS_WAIT(); asm volatile("" ::: "memory");
}
constexpr int CV_IN = 16 * 176, CV_BR = 8 * 32, CV_OUT = 16 * 32, CV_G = 16 * 16 * 16, CV_D = 16 * 8 * 32;
constexpr int N_EARLY = CV_IN + 2 * CV_BR + CV_OUT, N_LATE = 2 * CV_G + CV_D;
__device__ __forceinline__ CvItem cv_decode(const Frame& F, int it) {
    bf16* WinT = (bf16*)(F.ws + WS_WIN); bf16* WbrT = (bf16*)(F.ws + WS_WBR); bf16* WoutT = (bf16*)(F.ws + WS_WOUT); bf16* W1 = (bf16*)(F.ws + WS_W1); bf16* WdT = (bf16*)(F.ws + WS_WD);
    int r = it;
    if (r < CV_IN) { const int kb = r / 176, nb = r % 176, n0 = nb * 32; int drow = n0;
        if (n0 >= 4608) { const int c = n0 - 4608; drow = 3584 + (c >> 7) * 256 + 128 + (c & 127); } else if (n0 >= 3584) { const int c = n0 - 3584; drow = 3584 + (c >> 7) * 256 + (c & 127); }
        return CvItem{F.w_in + (size_t)(64 * kb) * IN_COLS + n0, WinT + (size_t)drow * 1024 + 64 * kb, IN_COLS, 1024}; } r -= CV_IN;
    if (r < CV_BR) { const int kb = r / 32, nb = r % 32; return CvItem{F.w_bsb + (size_t)(64 * kb) * 1024 + nb * 32, WbrT + (size_t)(nb * 32) * 512 + 64 * kb, 1024, 512}; } r -= CV_BR;
    if (r < CV_BR) { const int kb = r / 32, nb = r % 32; return CvItem{F.w_bhg + (size_t)(64 * kb) * 1024 + nb * 32, WbrT + (size_t)(1024 + nb * 32) * 512 + 64 * kb, 1024, 512}; } r -= CV_BR;
    if (r < CV_OUT) { const int kb = r / 32, nb = r % 32; return CvItem{F.w_out + (size_t)(64 * kb) * 1024 + nb * 32, WoutT + (size_t)(nb * 32) * 1024 + 64 * kb, 1024, 1024}; } r -= CV_OUT;
    if (r < 2 * CV_G) { const int up = r >= CV_G; if (up) r -= CV_G; const int e = r / 256, q = r % 256, kb = q / 16, nb = q % 16, n0 = nb * 32;
        const int drow = e * 1024 + (n0 >> 7) * 256 + (n0 & 127) + (up ? 128 : 0);
        return CvItem{(up ? F.w_eu : F.w_eg) + (size_t)e * 1024 * 512 + (size_t)(64 * kb) * 512 + n0, W1 + (size_t)drow * 1024 + 64 * kb, 512, 1024}; } r -= 2 * CV_G;
    { const int e = r / 256, q = r % 256, kb = q / 32, nb = q % 32;
      return CvItem{F.w_ed + (size_t)e * 512 * 1024 + (size_t)(64 * kb) * 1024 + nb * 32, WdT + (size_t)(e * 1024 + nb * 32) * 512 + 64 * kb, 1024, 512}; }
}
__device__ __forceinline__ void convert_range(const Frame& F, int first, int end, int stride, int base, LAS float* scr) {
    int it = first; if (it >= end) return;
    const int lane = F.lane;
    CvItem c = cv_decode(F, base + it); f32x4 v[8]; cv_load(c, v, lane);
    for (;;) {
        const int itn = it + stride;
        if (itn < end) { const CvItem cn = cv_decode(F, base + itn); f32x4 vn[8]; cv_load(cn, vn, lane); cv_finish(c, v, scr, lane); c = cn;
#pragma unroll
            for (int i = 0; i < 8; ++i) v[i] = vn[i];
            it = itn; }
        else { cv_finish(c, v, scr, lane); break; }
    }
}
__device__ __forceinline__ void p0_prologue(Frame& F) {
    LAS float* scr = (LAS float*)(F.lds + F.wave * 16384);
    const int gw = F.vcu * NWAVES + F.wave, NGW = F.G * NWAVES;
    convert_range(F, gw, N_EARLY, NGW, 0, scr);
    bf16* XN = (bf16*)(F.ws + WS_XN);
    f32x4 gv[4];
#pragma unroll
    for (int j = 0; j < 4; ++j) gv[j] = ((const GAS f32x4*)F.ln1_g)[F.lane + 64 * j];
    for (int m = gw; m < M; m += NGW) {
        const GAS f32x4* xr = (const GAS f32x4*)(F.x + (size_t)m * D) + F.lane;
        f32x4 v[4]; float s = 0.f;
#pragma unroll
        for (int j = 0; j < 4; ++j) { v[j] = xr[64 * j]; s += (v[j].x * v[j].x + v[j].y * v[j].y) + (v[j].z * v[j].z + v[j].w * v[j].w); }
        const float rstd = 1.0f / sqrtf(wave_sum(s) * (1.f / D) + EPS);
        GAS unsigned long long* o8 = (GAS unsigned long long*)(XN + (size_t)m * D) + F.lane;
#pragma unroll
        for (int j = 0; j < 4; ++j) { const f32x4 t = v[j] * rstd * gv[j]; o8[64 * j] = (unsigned long long)pk2(t.x, t.y) | ((unsigned long long)pk2(t.z, t.w) << 32); }
    }
}

typedef float f32x16 __attribute__((ext_vector_type(16)));
typedef short bf16x8v __attribute__((ext_vector_type(8)));
typedef short s16x4 __attribute__((ext_vector_type(4)));
typedef short v4i16_t __attribute__((ext_vector_type(4)));
__device__ __forceinline__ s16x4 vtr(const LAS unsigned char* p) { return __builtin_bit_cast(s16x4, __builtin_amdgcn_ds_read_tr16_b64_v4i16((LAS v4i16_t*)p)); }
__device__ __forceinline__ unsigned cvtpk(float lo, float hi) { typedef float f2 __attribute__((ext_vector_type(2))); typedef __bf16 b2 __attribute__((ext_vector_type(2))); f2 v = {lo, hi}; return __builtin_bit_cast(unsigned, __builtin_convertvector(v, b2)); }
__device__ __forceinline__ void sb_attn_unit_mfma(Frame& F, int unit, bf16* Ydst) {
    const int lane = F.lane, r32 = lane & 31, hi = lane >> 5;
    const int bh = unit >> 8, qb = unit & 255, b = bh >> 3, h = bh & 7, t0 = qb * 32;
    bf16* Qs = (bf16*)(F.ws + WS_QS); const bf16* Kb = (const bf16*)(F.ws + WS_KS) + (size_t)(b * SEQ) * HW + h * 64; const bf16* Vb = (const bf16*)(F.ws + WS_VS) + (size_t)(b * SEQ) * HW + h * 64;
    LAS unsigned char* vl = F.lds + F.wave * 8192;
    bf16x8v qf[4];
    { const bf16* Qg = Qs + (size_t)(b * SEQ + t0 + r32) * HW + h * 64 + hi * 8;
#pragma unroll
      for (int d0 = 0; d0 < 4; ++d0) qf[d0] = *(const bf16x8v*)(Qg + d0 * 16); }
    const int trow = t0 + r32;
    const int ktd = t0 >> 6;
    int kt = ktd;
    bf16x8v kf[8]; v4u vf[8];
#define SB_LOADK(T) do { const bf16* kp_ = Kb + (size_t)((T) * 64 + r32) * HW + hi * 8; _Pragma("unroll") for (int d0 = 0; d0 < 4; ++d0) { kf[d0] = *(const bf16x8v*)(kp_ + d0 * 16); kf[4 + d0] = *(const bf16x8v*)(kp_ + (size_t)32 * HW + d0 * 16); } } while (0)
#define SB_LOADV(T) do { const bf16* vp_ = Vb + (size_t)((T) * 64 + (lane >> 2)) * HW + (lane & 3) * 8; _Pragma("unroll") for (int p = 0; p < 8; ++p) vf[p] = *(const v4u*)(vp_ + (size_t)(16 * (p & 3)) * HW + (p >> 2) * 32); } while (0)
    SB_LOADK(kt); SB_LOADV(kt);
    f32x16 o0, o1;
#pragma unroll
    for (int r = 0; r < 16; ++r) { o0[r] = 0.f; o1[r] = 0.f; }
    float C = 1.0f;
    const LAS unsigned char* vb = vl + ((lane >> 4) & 1) * 32 + (lane & 3) * 8 + (4 * hi + ((lane & 15) >> 2)) * 64;
    constexpr float SC = 0.125f * 1.4426950408889634f, EXITP = 9.3576e-14f;
    for (;;) {
        f32x16 p0, p1;
#pragma unroll
        for (int r = 0; r < 16; ++r) { p0[r] = 0.f; p1[r] = 0.f; }
#pragma unroll
        for (int d0 = 0; d0 < 4; ++d0) { p0 = __builtin_amdgcn_mfma_f32_32x32x16_bf16(kf[d0], qf[d0], p0, 0, 0, 0); p1 = __builtin_amdgcn_mfma_f32_32x32x16_bf16(kf[4 + d0], qf[d0], p1, 0, 0, 0); }
#pragma unroll
        for (int p = 0; p < 8; ++p) *(LAS v4u*)(vl + p * 1024 + lane * 16) = vf[p];
        const int k0 = kt * 64; const bool diag = (kt == ktd);
        { const int ktn = kt > 0 ? kt - 1 : 0; SB_LOADK(ktn); SB_LOADV(ktn); }
        float s0[16], s1[16];
#pragma unroll
        for (int r = 0; r < 16; ++r) { p0[r] = __builtin_amdgcn_rcpf(1.0f + __builtin_amdgcn_exp2f(-p0[r] * SC)); p1[r] = __builtin_amdgcn_rcpf(1.0f + __builtin_amdgcn_exp2f(-p1[r] * SC)); s0[r] = 1.0f - p0[r]; s1[r] = 1.0f - p1[r]; }
        if (diag) {
#pragma unroll
            for (int r = 0; r < 16; ++r) { const int key = k0 + (r & 3) + 8 * (r >> 2) + 4 * hi; if (!(key < trow)) { p0[r] = 0.f; s0[r] = 1.0f; } if (!(key + 32 < trow)) { p1[r] = 0.f; s1[r] = 1.0f; } }
        }
#pragma unroll
        for (int rb = 0; rb < 4; ++rb) { s0[4 * rb + 2] *= s0[4 * rb + 3]; s0[4 * rb + 1] *= s0[4 * rb + 2]; s0[4 * rb] *= s0[4 * rb + 1];
                                         s1[4 * rb + 2] *= s1[4 * rb + 3]; s1[4 * rb + 1] *= s1[4 * rb + 2]; s1[4 * rb] *= s1[4 * rb + 1]; }
        float off0[4], off1[4]; float run = C;
#pragma unroll
        for (int rb = 3; rb >= 0; --rb) { const float me = s1[4 * rb], ot = __shfl_xor(me, 32); off1[rb] = run * (hi == 0 ? ot : 1.0f); run *= me * ot; }
#pragma unroll
        for (int rb = 3; rb >= 0; --rb) { const float me = s0[4 * rb], ot = __shfl_xor(me, 32); off0[rb] = run * (hi == 0 ? ot : 1.0f); run *= me * ot; }
#pragma unroll
        for (int rb = 0; rb < 4; ++rb) {
            p0[4 * rb] *= s0[4 * rb + 1] * off0[rb]; p0[4 * rb + 1] *= s0[4 * rb + 2] * off0[rb]; p0[4 * rb + 2] *= s0[4 * rb + 3] * off0[rb]; p0[4 * rb + 3] *= off0[rb];
            p1[4 * rb] *= s1[4 * rb + 1] * off1[rb]; p1[4 * rb + 1] *= s1[4 * rb + 2] * off1[rb]; p1[4 * rb + 2] *= s1[4 * rb + 3] * off1[rb]; p1[4 * rb + 3] *= off1[rb]; }
        C = run;
        v4u pw[4];
        pw[0] = (v4u){cvtpk(p0[0], p0[1]), cvtpk(p0[2], p0[3]), cvtpk(p0[4], p0[5]), cvtpk(p0[6], p0[7])};
        pw[1] = (v4u){cvtpk(p0[8], p0[9]), cvtpk(p0[10], p0[11]), cvtpk(p0[12], p0[13]), cvtpk(p0[14], p0[15])};
        pw[2] = (v4u){cvtpk(p1[0], p1[1]), cvtpk(p1[2], p1[3]), cvtpk(p1[4], p1[5]), cvtpk(p1[6], p1[7])};
        pw[3] = (v4u){cvtpk(p1[8], p1[9]), cvtpk(p1[10], p1[11]), cvtpk(p1[12], p1[13]), cvtpk(p1[14], p1[15])};
#pragma unroll
        for (int ks = 0; ks < 4; ++ks) {
            const s16x4 l0 = vtr(vb + ks * 1024), h0 = vtr(vb + ks * 1024 + 512), l1 = vtr(vb + 4096 + ks * 1024), h1 = vtr(vb + 4096 + ks * 1024 + 512);
            const bf16x8v b0 = (bf16x8v){l0[0], l0[1], l0[2], l0[3], h0[0], h0[1], h0[2], h0[3]}, b1 = (bf16x8v){l1[0], l1[1], l1[2], l1[3], h1[0], h1[1], h1[2], h1[3]};
            const bf16x8v pa = __builtin_bit_cast(bf16x8v, pw[ks]);
            o0 = __builtin_amdgcn_mfma_f32_32x32x16_bf16(pa, b0, o0, 0, 0, 0); o1 = __builtin_amdgcn_mfma_f32_32x32x16_bf16(pa, b1, o1, 0, 0, 0);
        }
        if (kt == 0) break;
        if (__all(C < EXITP)) break;
        --kt;
    }
#undef SB_LOADK
#undef SB_LOADV
    { bf16* yp = Ydst + (size_t)(b * SEQ + t0) * HW + h * 64 + r32;
#pragma unroll
      for (int r = 0; r < 16; ++r) { const int q = (r & 3) + 8 * (r >> 2) + 4 * hi; yp[(size_t)q * HW] = (bf16)f2bf(o0[r]); yp[(size_t)q * HW + 32] = (bf16)f2bf(o1[r]); } }
    LDS_WAIT();
}

__device__ __forceinline__ void hg_scan(Frame& F, int blk) {
    if (F.tid >= 256) return;
    const int gid = blk * 256 + F.tid;
    const int bh = gid >> 12, vk = gid & 4095, k = vk & 63;
    const bf16* S = (const bf16*)(F.ws + WS_XN) + (size_t)bh * 128 * 4096 + vk; const float* dec = (const float*)(F.ws + WS_SMALL + SM_DEC) + (size_t)(bh >> 3) * 128 * 512 + (bh & 7) * 64 + k;
    bf16* O = (bf16*)(F.ws + WS_SIN) + (size_t)bh * 128 * 4096 + vk;
    float run = 0.f;
    for (int c0 = 0; c0 < 128; c0 += 16) {
        float loc[16], d[16];
#pragma unroll
        for (int i = 0; i < 16; ++i) { loc[i] = bf2f(S[(size_t)(c0 + i) * 4096]); d[i] = dec[(c0 + i) * 512]; }
#pragma unroll
        for (int i = 0; i < 16; ++i) { O[(size_t)(c0 + i) * 4096] = (bf16)f2bf(run); run = run * d[i] + loc[i]; }
    }
}

template <int CTRL> __device__ __forceinline__ float dppf(float v) { return __builtin_bit_cast(float, __builtin_amdgcn_update_dpp(0, __builtin_bit_cast(int, v), CTRL, 0xF, 0xF, true)); }
__device__ __forceinline__ bf16x8v trfrag(const LAS unsigned char* p) { const s16x4 l = vtr(p), h = vtr(p + 512); return (bf16x8v){l[0], l[1], l[2], l[3], h[0], h[1], h[2], h[3]}; }
__device__ __forceinline__ void zero16(f32x16& a) {
#pragma unroll
    for (int r = 0; r < 16; ++r) a[r] = 0.f;
}
__device__ __forceinline__ void hg_local_mfma(Frame& F, int unit) {
    int lane_ = F.lane; asm volatile("" : "+v"(lane_));
    const int bh = unit >> 7, c = unit & 127, b = bh >> 3, h = bh & 7; const int lane = lane_, r32 = lane & 31, hi = lane >> 5;
    const size_t row0 = (size_t)b * SEQ + (size_t)c * 64;
    LAS unsigned char* kdI = F.lds + F.wave * 16384; LAS unsigned char* vI = kdI + 8192;
    { const bf16* vp_ = (const bf16*)(F.ws + WS_VH) + (row0 + (lane >> 2)) * HW + h * 64 + (lane & 3) * 8;
#pragma unroll
      for (int p = 0; p < 8; ++p) { const v4u t = *(const v4u*)(vp_ + (size_t)(16 * (p & 3)) * HW + (p >> 2) * 32); *(LAS v4u*)(vI + p * 1024 + lane * 16) = t; } }
    {
        const int k0 = (lane & 7) * 8, sr = lane >> 3;
        const bf16* kp = (const bf16*)(F.ws + WS_KH) + row0 * HW + h * 64 + k0;
#pragma unroll
        for (int i = 0; i < 8; ++i) { const int s2 = sr + 8 * i; const v4u kk = *(const v4u*)(kp + (size_t)s2 * HW);
            *(LAS v4u*)(kdI + ((k0 >> 5) * 4 + (s2 >> 4)) * 1024 + (s2 & 15) * 64 + (k0 & 31) * 2) = kk; }
    }
    const float* elm = (const float*)(F.ws + WS_SMALL + SM_ELM) + (size_t)(b * 128 + c) * 512 + h * 64 + r32;
    const float e0 = elm[0], e1 = elm[32];
    LDS_WAIT();
    const int vb = ((lane >> 4) & 1) * 32 + (lane & 3) * 8 + (4 * hi + ((lane & 15) >> 2)) * 64;
    f32x16 a00, a01, a10, a11; zero16(a00); zero16(a01); zero16(a10); zero16(a11);
#pragma unroll
    for (int ks = 0; ks < 4; ++ks) {
        const bf16x8v k0 = trfrag(kdI + vb + ks * 1024), k1 = trfrag(kdI + vb + 4096 + ks * 1024), v0 = trfrag(vI + vb + ks * 1024), v1 = trfrag(vI + vb + 4096 + ks * 1024);
        a00 = __builtin_amdgcn_mfma_f32_32x32x16_bf16(v0, k0, a00, 0, 0, 0); a01 = __builtin_amdgcn_mfma_f32_32x32x16_bf16(v0, k1, a01, 0, 0, 0);
        a10 = __builtin_amdgcn_mfma_f32_32x32x16_bf16(v1, k0, a10, 0, 0, 0); a11 = __builtin_amdgcn_mfma_f32_32x32x16_bf16(v1, k1, a11, 0, 0, 0);
    }
    bf16* Sl = (bf16*)(F.ws + WS_XN) + (size_t)unit * 4096 + r32;
#pragma unroll
    for (int r = 0; r < 16; ++r) { const int v = (r & 3) + 8 * (r >> 2) + 4 * hi;
        Sl[v * 64] = (bf16)f2bf(a00[r] * e0); Sl[v * 64 + 32] = (bf16)f2bf(a01[r] * e1); Sl[(v + 32) * 64] = (bf16)f2bf(a10[r] * e0); Sl[(v + 32) * 64 + 32] = (bf16)f2bf(a11[r] * e1); }
    LDS_WAIT();
}
__device__ __forceinline__ void hg_out_mfma(Frame& F, int unit) {
    int lane_ = F.lane; asm volatile("" : "+v"(lane_));
    const int bh = unit >> 7, c = unit & 127, b = bh >> 3, h = bh & 7; const int lane = lane_, r32 = lane & 31, hi = lane >> 5;
    const size_t row0 = (size_t)b * SEQ + (size_t)c * 64;
    LAS unsigned char* img = F.lds + F.wave * 8192;
    { const bf16* vp_ = (const bf16*)(F.ws + WS_VH) + (row0 + (lane >> 2)) * HW + h * 64 + (lane & 3) * 8;
#pragma unroll
      for (int p = 0; p < 8; ++p) { const v4u t = *(const v4u*)(vp_ + (size_t)(16 * (p & 3)) * HW + (p >> 2) * 32); *(LAS v4u*)(img + p * 1024 + lane * 16) = t; } }
    const bf16* SinT = (const bf16*)(F.ws + WS_SIN) + (size_t)unit * 4096 + (size_t)r32 * 64 + 8 * hi;
    const bf16* eap = (const bf16*)(F.ws + WS_LOGF) + row0 * HW + h * 64 + 8 * hi;
    const bf16* qp = (const bf16*)(F.ws + WS_QH) + row0 * HW + h * 64 + 8 * hi;
    const bf16* kp = (const bf16*)(F.ws + WS_KH) + row0 * HW + h * 64 + 8 * hi;
    const float* emp = (const float*)(F.ws + WS_SMALL + SM_EMID) + (size_t)(b * 128 + c) * 512 + h * 64 + 8 * hi;
    bf16x8v Af[2][4], Bf[2][4];
    f32x16 o00, o01, o10, o11; zero16(o00); zero16(o01); zero16(o10); zero16(o11);
#pragma unroll
    for (int ks = 0; ks < 4; ++ks) {
        const f32x4 e0_ = *(const f32x4*)(emp + 16 * ks), e1_ = *(const f32x4*)(emp + 16 * ks + 4);
        const float em[8] = {e0_.x, e0_.y, e0_.z, e0_.w, e1_.x, e1_.y, e1_.z, e1_.w};
        const bf16x8v sf0 = *(const bf16x8v*)(SinT + 16 * ks), sf1 = *(const bf16x8v*)(SinT + 32 * 64 + 16 * ks);
        bf16x8v As[2];
#pragma unroll
        for (int rb = 0; rb < 2; ++rb) { const size_t ro = (size_t)(32 * rb + r32) * HW + 16 * ks;
            const v4u qq = *(const v4u*)(qp + ro), kk = *(const v4u*)(kp + ro), ee = *(const v4u*)(eap + ro);
            const float a[8] = {blo(qq.x) * blo(ee.x), bhi(qq.x) * bhi(ee.x), blo(qq.y) * blo(ee.y), bhi(qq.y) * bhi(ee.y), blo(qq.z) * blo(ee.z), bhi(qq.z) * bhi(ee.z), blo(qq.w) * blo(ee.w), bhi(qq.w) * bhi(ee.w)};
            const v4u wa = (v4u){cvtpk(a[0], a[1]), cvtpk(a[2], a[3]), cvtpk(a[4], a[5]), cvtpk(a[6], a[7])};
            const v4u wb = kk;
            const v4u ws_ = (v4u){cvtpk(a[0] * em[0], a[1] * em[1]), cvtpk(a[2] * em[2], a[3] * em[3]), cvtpk(a[4] * em[4], a[5] * em[5]), cvtpk(a[6] * em[6], a[7] * em[7])};
            Af[rb][ks] = __builtin_bit_cast(bf16x8v, wa); Bf[rb][ks] = __builtin_bit_cast(bf16x8v, wb); As[rb] = __builtin_bit_cast(bf16x8v, ws_); }
        o00 = __builtin_amdgcn_mfma_f32_32x32x16_bf16(As[0], sf0, o00, 0, 0, 0); o01 = __builtin_amdgcn_mfma_f32_32x32x16_bf16(As[0], sf1, o01, 0, 0, 0);
        o10 = __builtin_amdgcn_mfma_f32_32x32x16_bf16(As[1], sf0, o10, 0, 0, 0); o11 = __builtin_amdgcn_mfma_f32_32x32x16_bf16(As[1], sf1, o11, 0, 0, 0);

    }
    f32x16 s00, s01, s11; zero16(s00); zero16(s01); zero16(s11);
#pragma unroll
    for (int ks = 0; ks < 4; ++ks) { s00 = __builtin_amdgcn_mfma_f32_32x32x16_bf16(Bf[0][ks], Af[0][ks], s00, 0, 0, 0); s01 = __builtin_amdgcn_mfma_f32_32x32x16_bf16(Bf[0][ks], Af[1][ks], s01, 0, 0, 0);
        s11 = __builtin_amdgcn_mfma_f32_32x32x16_bf16(Bf[1][ks], Af[1][ks], s11, 0, 0, 0); }
#pragma unroll
    for (int r = 0; r < 16; ++r) { const int sl = (r & 3) + 8 * (r >> 2) + 4 * hi; if (sl > r32) { s00[r] = 0.f; s11[r] = 0.f; } }
    v4u p00[2], p01[2], p11[2];
#pragma unroll
    for (int k2 = 0; k2 < 2; ++k2) {
        p00[k2] = (v4u){cvtpk(s00[8 * k2], s00[8 * k2 + 1]), cvtpk(s00[8 * k2 + 2], s00[8 * k2 + 3]), cvtpk(s00[8 * k2 + 4], s00[8 * k2 + 5]), cvtpk(s00[8 * k2 + 6], s00[8 * k2 + 7])};
        p01[k2] = (v4u){cvtpk(s01[8 * k2], s01[8 * k2 + 1]), cvtpk(s01[8 * k2 + 2], s01[8 * k2 + 3]), cvtpk(s01[8 * k2 + 4], s01[8 * k2 + 5]), cvtpk(s01[8 * k2 + 6], s01[8 * k2 + 7])};
        p11[k2] = (v4u){cvtpk(s11[8 * k2], s11[8 * k2 + 1]), cvtpk(s11[8 * k2 + 2], s11[8 * k2 + 3]), cvtpk(s11[8 * k2 + 4], s11[8 * k2 + 5]), cvtpk(s11[8 * k2 + 6], s11[8 * k2 + 7])};
    }
    LDS_WAIT();
    const int vb = ((lane >> 4) & 1) * 32 + (lane & 3) * 8 + (4 * hi + ((lane & 15) >> 2)) * 64;
#pragma unroll
    for (int k2 = 0; k2 < 2; ++k2) {
        const bf16x8v v0a = trfrag(img + vb + k2 * 1024), v1a = trfrag(img + vb + 4096 + k2 * 1024);
        const bf16x8v v0b = trfrag(img + vb + (2 + k2) * 1024), v1b = trfrag(img + vb + 4096 + (2 + k2) * 1024);
        const bf16x8v a00 = __builtin_bit_cast(bf16x8v, p00[k2]), a01 = __builtin_bit_cast(bf16x8v, p01[k2]), a11 = __builtin_bit_cast(bf16x8v, p11[k2]);
        o00 = __builtin_amdgcn_mfma_f32_32x32x16_bf16(a00, v0a, o00, 0, 0, 0); o01 = __builtin_amdgcn_mfma_f32_32x32x16_bf16(a00, v1a, o01, 0, 0, 0);
        o10 = __builtin_amdgcn_mfma_f32_32x32x16_bf16(a01, v0a, o10, 0, 0, 0); o11 = __builtin_amdgcn_mfma_f32_32x32x16_bf16(a01, v1a, o11, 0, 0, 0);
        o10 = __builtin_amdgcn_mfma_f32_32x32x16_bf16(a11, v0b, o10, 0, 0, 0); o11 = __builtin_amdgcn_mfma_f32_32x32x16_bf16(a11, v1b, o11, 0, 0, 0);
    }
    LDS_WAIT();
    { LAS bf16* ot = (LAS bf16*)img + r32;
#pragma unroll
      for (int r = 0; r < 16; ++r) { const int t = (r & 3) + 8 * (r >> 2) + 4 * hi;
          ot[t * 64] = (bf16)f2bf(o00[r]); ot[t * 64 + 32] = (bf16)f2bf(o01[r]); ot[(t + 32) * 64] = (bf16)f2bf(o10[r]); ot[(t + 32) * 64 + 32] = (bf16)f2bf(o11[r]); } }
    LDS_WAIT();
    { int lane2 = lane; asm volatile("" : "+v"(lane2));
      const int v0e = (lane2 & 7) * 8, tre = lane2 >> 3; const bf16* ghp = (const bf16*)(F.ws + WS_GH) + row0 * HW + h * 64 + v0e;
      const f32x4 g0 = *(const f32x4*)(F.hg_norm_g + h * 64 + v0e), g1 = *(const f32x4*)(F.hg_norm_g + h * 64 + v0e + 4);
      bf16* yp = (bf16*)(F.ws + WS_KS) + row0 * HW + h * 64 + v0e;
#pragma unroll
      for (int i = 0; i < 8; ++i) { const int t = tre + 8 * i;
          const v4u ov = *(const LAS v4u*)(img + t * 128 + v0e * 2); const v4u gg = *(const v4u*)(ghp + (size_t)t * HW);
          const float o[8] = {blo(ov.x), bhi(ov.x), blo(ov.y), bhi(ov.y), blo(ov.z), bhi(ov.z), blo(ov.w), bhi(ov.w)};
          float q = (o[0] * o[0] + o[1] * o[1]) + (o[2] * o[2] + o[3] * o[3]) + (o[4] * o[4] + o[5] * o[5]) + (o[6] * o[6] + o[7] * o[7]);
          q += dppf<0xB1>(q); q += dppf<0x4E>(q); q += dppf<0x141>(q);
          const float rs = 1.0f / sqrtf(q * (1.f / 64.f) + EPS);
          v4u w; w.x = cvtpk(o[0] * rs * g0.x * blo(gg.x), o[1] * rs * g0.y * bhi(gg.x)); w.y = cvtpk(o[2] * rs * g0.z * blo(gg.y), o[3] * rs * g0.w * bhi(gg.y));
          w.z = cvtpk(o[4] * rs * g1.x * blo(gg.z), o[5] * rs * g1.y * bhi(gg.z)); w.w = cvtpk(o[6] * rs * g1.z * blo(gg.w), o[7] * rs * g1.w * bhi(gg.w));
          *(v4u*)(yp + (size_t)t * HW) = w; } }
    LDS_WAIT();
}

__device__ __forceinline__ void router_phase(Frame& F) {
    LAS float* xs = (LAS float*)(F.lds + F.wave * 11136);
    LAS float* We = xs + 64 * 33;
    LAS float* Wg = We + 32 * 16;
    LAS float* Gc = Wg + 32 * 4;
    LAS float* part = (LAS float*)(F.lds + 8 * 11136);
    LAS int* lh = (LAS int*)(F.lds + 8 * 11136 + 8 * 21 * 64 * 4);
    LAS float* lrs = (LAS float*)(lh + 16);
    const int lane = F.lane;
    int* tok_e = (int*)(F.ws + WS_SMALL + SM_TOKE); float* tok_w = (float*)(F.ws + WS_SMALL + SM_TOKW); float* tok_r = (float*)(F.ws + WS_SMALL + SM_RSTD);
    for (int blk = F.vcu; blk < M / 64; blk += F.G) {
        if (F.tid < 16) lh[F.tid] = 0;
        float ss = 0.f, ag[4] = {0.f, 0.f, 0.f, 0.f}, ae[16];
#pragma unroll
        for (int j = 0; j < 16; ++j) ae[j] = 0.f;
        const bf16* xb = (const bf16*)(F.ws + WS_X1) + (size_t)(blk * 64) * D + F.wave * 128;
        v4u v[4]; f32x4 we0, we1, wg, gg;
#define RT_LOAD(CH) do { const int c0_ = F.wave * 128 + (CH) * 32; \
            _Pragma("unroll") for (int j = 0; j < 4; ++j) v[j] = *(const GAS v4u*)(xb + (size_t)((lane >> 2) + 16 * j) * D + (CH) * 32 + (lane & 3) * 8); \
            we0 = *(const GAS f32x4*)(F.w_re + (size_t)c0_ * 16 + lane * 4); we1 = *(const GAS f32x4*)(F.w_re + (size_t)c0_ * 16 + 256 + lane * 4); \
            wg = *(const GAS f32x4*)(F.w_rg + (size_t)c0_ * 4 + (lane & 31) * 4); gg = *(const GAS f32x4*)(F.ln2_g + c0_ + (lane & 7) * 4); } while (0)
        RT_LOAD(0);
        for (int ch = 0; ch < 4; ++ch) {
#pragma unroll
            for (int j = 0; j < 4; ++j) { LAS float* d = xs + ((lane >> 2) + 16 * j) * 33 + (lane & 3) * 8; d[0] = blo(v[j].x); d[1] = bhi(v[j].x); d[2] = blo(v[j].y); d[3] = bhi(v[j].y); d[4] = blo(v[j].z); d[5] = bhi(v[j].z); d[6] = blo(v[j].w); d[7] = bhi(v[j].w); }
            *(LAS f32x4*)(We + lane * 4) = we0; *(LAS f32x4*)(We + 256 + lane * 4) = we1;
            if (lane < 32) *(LAS f32x4*)(Wg + lane * 4) = wg;
            if (lane < 8) *(LAS f32x4*)(Gc + lane * 4) = gg;
            LDS_WAIT();
            if (ch < 3) RT_LOAD(ch + 1);
#pragma unroll 4
            for (int cc = 0; cc < 32; ++cc) {
                const float xv = xs[lane * 33 + cc]; const float xg = xv * Gc[cc];
                ss += xv * xv;
                const f32x4 g4 = *(const LAS f32x4*)(Wg + cc * 4);
                ag[0] += xg * g4.x; ag[1] += xg * g4.y; ag[2] += xg * g4.z; ag[3] += xg * g4.w;
#pragma unroll
                for (int r = 0; r < 4; ++r) { const f32x4 e4 = *(const LAS f32x4*)(We + cc * 16 + 4 * r);
                    ae[4 * r] += xg * e4.x; ae[4 * r + 1] += xg * e4.y; ae[4 * r + 2] += xg * e4.z; ae[4 * r + 3] += xg * e4.w; }
            }
            LDS_WAIT();
        }
#undef RT_LOAD
        part[(F.wave * 21 + 0) * 64 + lane] = ss;
#pragma unroll
        for (int j = 0; j < 4; ++j) part[(F.wave * 21 + 1 + j) * 64 + lane] = ag[j];
#pragma unroll
        for (int j = 0; j < 16; ++j) part[(F.wave * 21 + 5 + j) * 64 + lane] = ae[j];
        __syncthreads();
        if (F.wave == 0) {
            const int tok = blk * 64 + lane;
            ss = 0.f;
#pragma unroll
            for (int j = 0; j < 4; ++j) ag[j] = 0.f;
#pragma unroll
            for (int j = 0; j < 16; ++j) ae[j] = 0.f;
#pragma unroll
            for (int w = 0; w < 8; ++w) { ss += part[(w * 21) * 64 + lane];
#pragma unroll
                for (int j = 0; j < 4; ++j) ag[j] += part[(w * 21 + 1 + j) * 64 + lane];
#pragma unroll
                for (int j = 0; j < 16; ++j) ae[j] += part[(w * 21 + 5 + j) * 64 + lane]; }
            const float rstd = 1.0f / sqrtf(ss * (1.f / D) + EPS);
            float gl[4];
#pragma unroll
            for (int j = 0; j < 4; ++j) gl[j] = ag[j] * rstd + F.b_rg[j];
            int gi = 0; float gm = gl[0];
#pragma unroll
            for (int j = 1; j < 4; ++j) if (gl[j] > gm) { gm = gl[j]; gi = j; }
            float den = 0.f;
#pragma unroll
            for (int j = 0; j < 4; ++j) den += __expf(gl[j] - gm);
            const float wgrp = 1.0f / den;
            float el[4];
#pragma unroll
            for (int q = 0; q < 4; ++q) { float v = ae[q]; float bb = F.b_re[q];
#pragma unroll
                for (int g2 = 1; g2 < 4; ++g2) { v = (gi == g2) ? ae[g2 * 4 + q] : v; bb = (gi == g2) ? F.b_re[g2 * 4 + q] : bb; }
                el[q] = v * rstd + bb; }
            int i0 = 0; float v0 = el[0];
#pragma unroll
            for (int q = 1; q < 4; ++q) if (el[q] > v0) { v0 = el[q]; i0 = q; }
            int i1 = -1; float v1 = 0.f;
#pragma unroll
            for (int q = 0; q < 4; ++q) if (q != i0 && (i1 < 0 || el[q] > v1)) { v1 = el[q]; i1 = q; }
            const float ex = __expf(v1 - v0); const float p0 = 1.0f / (1.0f + ex), p1 = ex / (1.0f + ex);
            const int e0 = gi * 4 + i0, e1 = gi * 4 + i1;
            *(v2u*)(tok_e + tok * 2) = (v2u){(unsigned)e0, (unsigned)e1};
            typedef float f32x2 __attribute__((ext_vector_type(2)));
            *(f32x2*)(tok_w + tok * 2) = (f32x2){p0 * wgrp, p1 * wgrp}; tok_r[tok] = rstd; lrs[lane] = rstd;
            __hip_atomic_fetch_add(&lh[e0], 1, __ATOMIC_RELAXED, __HIP_MEMORY_SCOPE_WORKGROUP); __hip_atomic_fetch_add(&lh[e1], 1, __ATOMIC_RELAXED, __HIP_MEMORY_SCOPE_WORKGROUP);
        }
        __syncthreads();
        if (F.tid < 16) ((int*)(F.ws + WS_SMALL + SM_HIST))[blk * 16 + F.tid] = lh[F.tid];
        {
            bf16* TN = (bf16*)(F.ws + WS_TS); f32x4 gq[4];
#pragma unroll
            for (int j = 0; j < 4; ++j) gq[j] = ((const GAS f32x4*)F.ln2_g)[lane + 64 * j];
            for (int i0 = 0; i0 < 8; i0 += 4) {
                v2u xv[4][4];
#pragma unroll
                for (int u = 0; u < 4; ++u) { const GAS v2u* xr = (const GAS v2u*)((const bf16*)(F.ws + WS_X1) + (size_t)(blk * 64 + F.wave * 8 + i0 + u) * D) + lane;
#pragma unroll
                    for (int j = 0; j < 4; ++j) xv[u][j] = xr[64 * j]; }
#pragma unroll
                for (int u = 0; u < 4; ++u) { const int tl = F.wave * 8 + i0 + u; const float rs = lrs[tl];
                    GAS unsigned long long* o0 = (GAS unsigned long long*)(TN + (size_t)(blk * 64 + tl) * D) + lane;
#pragma unroll
                    for (int j = 0; j < 4; ++j) { const f32x4 t = (f32x4){blo(xv[u][j].x), bhi(xv[u][j].x), blo(xv[u][j].y), bhi(xv[u][j].y)} * rs * gq[j]; o0[64 * j] = (unsigned long long)pk2(t.x, t.y) | ((unsigned long long)pk2(t.z, t.w) << 32); } }
            }
        }
        __syncthreads();
    }
}

__device__ __forceinline__ void sort_gather_phase(Frame& F) {
    LAS int* L = (LAS int*)(F.lds);
    const int* hist = (const int*)(F.ws + WS_SMALL + SM_HIST);
    int* rowtok = (int*)(F.ws + WS_SMALL + SM_ROWTOK); float* roww = (float*)(F.ws + WS_SMALL + SM_ROWW);
    const int* tok_e = (const int*)(F.ws + WS_SMALL + SM_TOKE); const float* tok_w = (const float*)(F.ws + WS_SMALL + SM_TOKW); const float* tok_r = (const float*)(F.ws + WS_SMALL + SM_RSTD);
    const int lane = F.lane;
    for (int blk = F.vcu; blk < M / 64; blk += F.G) {
        if (F.tid < 32) L[F.tid] = 0;
        __syncthreads();
        { const int e = F.tid & 15, bg = F.tid >> 4; int tot = 0, base = 0;
#pragma unroll
          for (int i = 0; i < 8; ++i) { const int b2 = bg + 32 * i; const int hv = hist[b2 * 16 + e]; tot += hv; base += (b2 < blk) ? hv : 0; }
          __hip_atomic_fetch_add(&L[e], tot, __ATOMIC_RELAXED, __HIP_MEMORY_SCOPE_WORKGROUP); __hip_atomic_fetch_add(&L[16 + e], base, __ATOMIC_RELAXED, __HIP_MEMORY_SCOPE_WORKGROUP); }
        __syncthreads();
        if (F.tid == 0) { int p = 0; for (int e = 0; e < 16; ++e) { L[32 + e] = p; L[64 + e] = p * 256; p += (L[e] + 255) >> 8; } L[48] = p;
            if (blk == 0) { int* meta = (int*)(F.ws + WS_SMALL + SM_META); for (int e = 0; e <= 16; ++e) meta[e] = L[32 + e]; } }
        __syncthreads();
        if (F.wave == 0) {
            int run[16];
#pragma unroll
            for (int e = 0; e < 16; ++e) run[e] = 0;
            for (int r = 0; r < 2; ++r) {
                const int i = r * 64 + lane, tok = blk * 64 + (i >> 1), slot = i & 1; const int e = tok_e[tok * 2 + slot]; int pos = 0;
#pragma unroll
                for (int ex = 0; ex < 16; ++ex) { const unsigned long long mk = __ballot(e == ex); const int below = __popcll(mk & ((1ull << lane) - 1ull));
                    if (e == ex) pos = L[64 + ex] + L[16 + ex] + run[ex] + below; run[ex] += __popcll(mk); }
                L[128 + i] = pos; rowtok[pos] = tok * 2 + slot; roww[pos] = tok_w[tok * 2 + slot];
            }
        }
        __syncthreads();
        if (blk < 16) {
            const int first = L[64 + blk] + L[blk], end = L[64 + blk] + (((L[blk] + 255) >> 8) << 8);
            for (int r = first + F.tid; r < end; r += NWAVES * 64) { rowtok[r] = -1; roww[r] = 0.f; }
        }
        __syncthreads();
    }
}

__device__ __forceinline__ void final_phase(Frame& F) {
    const int gw = F.vcu * NWAVES + F.wave, NGW = F.G * NWAVES; const int lane = F.lane;
    const bf16* Y0 = (const bf16*)(F.ws + WS_XN); const bf16* Y1 = (const bf16*)(F.ws + WS_Y1);
    f32x4 gv[4];
#pragma unroll
    for (int j = 0; j < 4; ++j) gv[j] = ((const GAS f32x4*)F.final_g)[lane + 64 * j];
    for (int m0 = gw; m0 < M; m0 += 2 * NGW) {
        f32x4 v[2][4]; float s[2];
#pragma unroll
        for (int u = 0; u < 2; ++u) { const int m = m0 + u * NGW;
            const GAS v2u* xr = (const GAS v2u*)((const bf16*)(F.ws + WS_X1) + (size_t)m * D) + lane;
            const GAS v2u* y0 = (const GAS v2u*)(Y0 + (size_t)m * D) + lane; const GAS v2u* y1 = (const GAS v2u*)(Y1 + (size_t)m * D) + lane;
            s[u] = 0.f;
#pragma unroll
            for (int j = 0; j < 4; ++j) { const v2u a = y0[64 * j], b2 = y1[64 * j], xw = xr[64 * j]; f32x4 t = (f32x4){blo(xw.x), bhi(xw.x), blo(xw.y), bhi(xw.y)};
                t.x += blo(a.x) + blo(b2.x); t.y += bhi(a.x) + bhi(b2.x); t.z += blo(a.y) + blo(b2.y); t.w += bhi(a.y) + bhi(b2.y);
                v[u][j] = t; s[u] += (t.x * t.x + t.y * t.y) + (t.z * t.z + t.w * t.w); } }
#pragma unroll
        for (int u = 0; u < 2; ++u) { const int m = m0 + u * NGW; GAS f32x4* xr = (GAS f32x4*)(F.out + (size_t)m * D) + lane;
            const float rstd = 1.0f / sqrtf(wave_sum(s[u]) * (1.f / D) + EPS);
#pragma unroll
            for (int j = 0; j < 4; ++j) xr[64 * j] = v[u][j] * rstd * gv[j]; }
    }
}

struct Args { const float* in[17]; float* out; unsigned char* ws; int ph_lo, ph_hi, li, pad; };
__global__ void __launch_bounds__(NWAVES * 64, 2) hybrid_fwd(Args args) {
    extern __shared__ __attribute__((aligned(16))) unsigned char lds[];
    Frame F;
    F.lds = (LAS unsigned char*)lds;
    F.MISC = (volatile LAS unsigned*)(F.lds + MISC_OFF);
    F.tid = threadIdx.x; F.lane = F.tid & 63; F.wave = __builtin_amdgcn_readfirstlane(F.tid >> 6);
    F.G = gridDim.x; { const int bx = blockIdx.x; F.vcu = (F.G % 8 == 0) ? (bx % 8) * (F.G / 8) + bx / 8 : bx; }
    unsigned char* ws = args.ws; F.ws = ws;
    F.ctl = (gu32*)(ws + WS_CTL);
    for (int u = F.tid; u < (LDS_BYTES - LDSCTL_OFF) / 4; u += NWAVES * 64) ((LAS unsigned*)(F.lds + LDSCTL_OFF))[u] = 0u;
    __syncthreads();
    F.PT = (volatile LAS unsigned long long*)(F.lds + LDSCTL_OFF + 512);
#pragma unroll
    for (int k = 0; k < 17; ++k) if (F.tid == k) F.PT[k] = (unsigned long long)args.in[k];
    __syncthreads();
    F.out = args.out;
    XcdBarrier bar; bar.bar = g_grid_barrier; bar.x = 0; bar.st = nullptr;
    if (N_LAUNCHES == 1) bar = xcd_barrier_post(g_grid_barrier, F.MISC + 8);
#if defined(PROBE_A0)
#define TS_MARK(i) do { if (threadIdx.x == 0) ((volatile LAS unsigned long long*)(F.lds + LDSCTL_OFF + 1024))[(i)] = __builtin_amdgcn_s_memrealtime(); } while (0)
#else
#define TS_MARK(i) do {} while (0)
#endif
    int nbar = 0;
    TS_MARK(0);
#define GRID_BAR() do { if (N_LAUNCHES == 1) { TS_MARK(1 + 2 * nbar); xcd_barrier(bar); TS_MARK(2 + 2 * nbar); ++nbar; } } while (0)
    const int lo = args.ph_lo, hi = args.ph_hi;
#ifndef PH_MASK
#define PH_MASK 0xFFF
#endif
#define IN(k) ((((PH_MASK) >> (k)) & 1) && lo <= (k) && (k) < hi)
#define BOTH(k) (IN(k) && IN((k) + 1))
#ifndef REP_MASK
#define REP_MASK 0
#endif
#ifndef REP_N
#define REP_N 3
#endif
#define REPF(k) for (int rep_ = 0; rep_ < 1 + ((((REP_MASK) >> (k)) & 1) ? (REP_N) : 0); ++rep_)
#define OPAQUE() do { int t_ = threadIdx.x; asm volatile("" : "+v"(t_)); F.tid = t_; F.lane = t_ & 63; } while (0)
    const int gw = F.vcu * NWAVES + F.wave, NGW = F.G * NWAVES;

    if (IN(0)) { OPAQUE(); } if (IN(0)) REPF(0) { F.x = fin(F, 0); F.ln1_g = fin(F, 1); F.w_in = fin(F, 2); F.w_bsb = fin(F, 3); F.w_bhg = fin(F, 4); F.w_out = fin(F, 7); F.w_eg = fin(F, 13); F.w_eu = fin(F, 14); F.w_ed = fin(F, 15); p0_prologue(F); if (BOTH(0)) GRID_BAR(); }

    if (IN(1)) REPF(1) {
        F.lbl = fin(F, 6); F.w_eg = fin(F, 13); F.w_eu = fin(F, 14); F.w_ed = fin(F, 15); F.w_in = fin(F, 2); F.w_bsb = fin(F, 3); F.w_bhg = fin(F, 4); F.w_out = fin(F, 7);
        pg8::Gemm g{(const bf16*)(ws + WS_XN), (const bf16*)(ws + WS_WIN), M, IN_COLS, D}; pg8::StaticOrder S; S.init(M, IN_COLS, F.G, (int)blockIdx.x);
        pg8::EpiProj E{(bf16*)(ws + WS_QS), (bf16*)(ws + WS_KS), (bf16*)(ws + WS_VS), (bf16*)(ws + WS_QH), (bf16*)(ws + WS_KH), (bf16*)(ws + WS_VH), (bf16*)(ws + WS_GH),
                       (bf16*)F.out, (bf16*)F.out + (size_t)M * D, (float*)(ws + WS_LOGF), (float*)(ws + WS_SMALL + SM_EMID), (float*)(ws + WS_SMALL + SM_ELM), (float*)(ws + WS_SMALL + SM_DEC), F.lbl};
        pg8::gemm_phase<pg8::EpiProj, pg8::StaticOrder, PG8_ALIGN, PG8_SP2>(F.lds, g, S, E);
        {
            const int nfull = S.nwg % F.G, c = (int)blockIdx.x; const int nshort = nfull ? F.G - nfull : F.G, idx = nfull ? c - nfull : c;
            if (idx >= 0) { OPAQUE(); LAS float* scr = (LAS float*)(F.lds + F.wave * 16384);
                convert_range(F, idx * NWAVES + F.wave, N_LATE, nshort * NWAVES, N_EARLY, scr); }
        }
        if (BOTH(1)) GRID_BAR();
    }

    if (IN(2)) { OPAQUE(); } if (IN(2)) REPF(2) {
        for (int u = gw; u < 2048; u += NGW) hg_local_mfma(F, u);
        if (BOTH(2)) GRID_BAR();
    }

    if (IN(3)) { OPAQUE(); } if (IN(3)) {
        LAS int* aq = (LAS int*)(F.lds + LDSCTL_OFF + 256);
        if (F.tid == 0) aq[0] = 0;
        __syncthreads();
        for (int blk = F.vcu; blk < 256; blk += F.G) hg_scan(F, blk);
        for (;;) { int u = 0; if (F.lane == 0) u = __hip_atomic_fetch_add(aq, 1, __ATOMIC_RELAXED, __HIP_MEMORY_SCOPE_WORKGROUP);
            u = __builtin_amdgcn_readfirstlane(u); const int unit = F.vcu + u * F.G; if (unit >= 4096) break;
            sb_attn_unit_mfma(F, unit, (bf16*)(ws + WS_QS)); }
        if (BOTH(3)) GRID_BAR(); }

    if (IN(4)) { OPAQUE(); } if (IN(4)) REPF(4) { F.hg_norm_g = fin(F, 5); for (int u = gw; u < 2048; u += NGW) hg_out_mfma(F, u); if (BOTH(4)) GRID_BAR(); }

    if (IN(5)) REPF(5) {
        pg8::Gemm g{(const bf16*)(ws + WS_QS), (const bf16*)(ws + WS_WBR), 2 * M, 2048, HW}; pg8::BranchOrder S; S.S.init(M, D, F.G, (int)blockIdx.x);
        pg8::EpiBranch E{(const bf16*)F.out, (const bf16*)F.out + (size_t)M * D, (bf16*)(ws + WS_XN)};
        for (int r = 0; r * F.G < 256; ++r) { S.S.c = (int)blockIdx.x + r * F.G; pg8::gemm_phase<pg8::EpiBranch, pg8::BranchOrder, false, PG8_SP2>(F.lds, g, S, E); }
        if (BOTH(5)) GRID_BAR();
    }

    if (IN(6)) REPF(6) {
        pg8::Gemm g{(const bf16*)(ws + WS_XN), (const bf16*)(ws + WS_WOUT), M, D, D}; pg8::StaticOrder S; S.init(M, D, F.G, (int)blockIdx.x);
        pg8::EpiResBf16 E{fin(F, 0), (bf16*)(ws + WS_X1)};
        pg8::gemm_phase<pg8::EpiResBf16, pg8::StaticOrder, PG8_ALIGN, PG8_SP2>(F.lds, g, S, E);
        if (BOTH(6)) GRID_BAR();
    }

    if (IN(7)) { OPAQUE(); } if (IN(7)) REPF(7) { F.ln2_g = fin(F, 8); F.w_rg = fin(F, 9); F.b_rg = fin(F, 10); F.w_re = fin(F, 11); F.b_re = fin(F, 12); router_phase(F); if (BOTH(7)) GRID_BAR(); }

    if (IN(8)) { OPAQUE(); } if (IN(8)) REPF(8) { F.ln2_g = fin(F, 8); sort_gather_phase(F); if (BOTH(8)) GRID_BAR(); }

    if (IN(9) || IN(10)) {
        LAS int* tp = (LAS int*)(F.lds + LDSCTL_OFF);
        if (F.tid <= 16) tp[F.tid] = ((const int*)(ws + WS_SMALL + SM_META))[F.tid];
        __syncthreads();
    }
    if (IN(9)) REPF(9) {
        const LAS int* tp = (const LAS int*)(F.lds + LDSCTL_OFF);
        pg8::Gemm g{(const bf16*)(ws + WS_TS), (const bf16*)(ws + WS_W1), MOE_ROWS, NEXP * 1024, D}; pg8::MoeOrder S{tp[16] * 4, F.G, (int)blockIdx.x, tp};
        pg8::EpiMoeUp E{(bf16*)(ws + WS_H)};
        pg8::gemm_phase<pg8::EpiMoeUp, pg8::MoeOrder, PG8_ALIGN, true, true>(F.lds, g, S, E, (const int*)(ws + WS_SMALL + SM_ROWTOK));
        if (BOTH(9)) GRID_BAR();
    }
    if (IN(10)) REPF(10) {
        const LAS int* tp = (const LAS int*)(F.lds + LDSCTL_OFF);
        pg8::Gemm g{(const bf16*)(ws + WS_H), (const bf16*)(ws + WS_WD), MOE_ROWS, NEXP * 1024, DEXP}; pg8::MoeOrder S{tp[16] * 4, F.G, (int)blockIdx.x, tp};
        pg8::EpiMoeDown E{(const int*)(ws + WS_SMALL + SM_ROWTOK), (const float*)(ws + WS_SMALL + SM_ROWW), (bf16*)(ws + WS_XN), (bf16*)(ws + WS_Y1)};
        pg8::gemm_phase<pg8::EpiMoeDown, pg8::MoeOrder, PG8_ALIGN, PG8_SP2>(F.lds, g, S, E);
        if (BOTH(10)) GRID_BAR();
    }

    if (IN(11)) { OPAQUE(); } if (IN(11)) { F.final_g = fin(F, 16); final_phase(F); }
#ifdef PROBE_A0
    {
        asm volatile("s_waitcnt vmcnt(0)" ::: "memory"); __syncthreads(); TS_MARK(23);
        if ((int)blockIdx.x == (PROBE_BLK) && threadIdx.x == 0) { volatile LAS unsigned long long* T = (volatile LAS unsigned long long*)(F.lds + LDSCTL_OFF + 1024);
            const unsigned long long dA = T[PROBE_A1] - T[PROBE_A0], dB = T[PROBE_B1] - T[PROBE_B0];
            const unsigned long long extra = dA * (PROBE_WA) + ((dB + 50ull) / 100ull) * (100ull * (PROBE_QB)) + (PROBE_CT);
            const unsigned long long t0 = __builtin_amdgcn_s_memrealtime();
            while (__builtin_amdgcn_s_memrealtime() - t0 < extra) __builtin_amdgcn_s_sleep(8); }
    }
#endif
    if (N_LAUNCHES == 1 && threadIdx.x == 0) {
        unsigned* bw = g_grid_barrier;
        if (xb_add(&bw[XB_EXIT], 1u) == (unsigned)gridDim.x - 1u) {
            for (unsigned j = 0; j < 16; ++j) { __hip_atomic_store(&bw[XB_XCNT(j)], 0u, RLX_AGENT); __hip_atomic_store(&bw[XB_XSUB(j)], 0u, RLX_AGENT); __hip_atomic_store(&bw[XB_XGEN(j)], 0u, RLX_AGENT); }
            __hip_atomic_store(&bw[XB_TOP], 0u, RLX_AGENT); __hip_atomic_store(&bw[XB_TOPGEN], 0u, RLX_AGENT); __hip_atomic_store(&bw[XB_TMO], 0u, RLX_AGENT); __hip_atomic_store(&bw[XB_EXIT], 0u, RLX_AGENT);
        }
    }
#undef IN
#undef BOTH
#undef GRID_BAR
}

extern "C" void kernel_launch(void* const* d_in, const int* in_sizes, int n_in, void* d_out, int out_size, void* d_ws, size_t ws_size, hipStream_t stream) {
    static int grid = 0;
    if (grid == 0) {
        if (n_in != 17 || in_sizes[0] != M * D || out_size != M * D || ws_size < WS_END) { fprintf(stderr, "kernel_launch: unexpected shapes (n_in %d, in0 %d, out %d, ws %zu); nothing launched\n", n_in, n_in > 0 ? in_sizes[0] : -1, out_size, ws_size); grid = -1; return; }
        int dev = 0, cus = 0, per_cu = 0;
        if (hipGetDevice(&dev) != hipSuccess || hipDeviceGetAttribute(&cus, hipDeviceAttributeMultiprocessorCount, dev) != hipSuccess) { grid = -1; return; }
        if (hipFuncSetAttribute((const void*)hybrid_fwd, hipFuncAttributeMaxDynamicSharedMemorySize, LDS_BYTES) != hipSuccess) { fprintf(stderr, "kernel_launch: hipFuncSetAttribute failed\n"); grid = -1; return; }
        if (hipOccupancyMaxActiveBlocksPerMultiprocessor(&per_cu, (const void*)hybrid_fwd, NWAVES * 64, LDS_BYTES) != hipSuccess || per_cu < 1)
            fprintf(stderr, "kernel_launch: note: occupancy query reports %d workgroups per CU\n", per_cu);
        (void)hipGetLastError();
        grid = cus;
    }
    if (grid < 0) return;
    Args a{};
    for (int i = 0; i < 17; ++i) a.in[i] = (const float*)d_in[i];
    a.out = (float*)d_out; a.ws = (unsigned char*)d_ws;
    if (N_LAUNCHES == 1) {
        a.ph_lo = 0; a.ph_hi = N_PHASES; a.li = 0;
        hipLaunchKernelGGL(hybrid_fwd, dim3(grid), dim3(NWAVES * 64), LDS_BYTES, stream, a);
    } else {
        for (int li = 0; li < N_PHASES; ++li) { a.ph_lo = li; a.ph_hi = li + 1; a.li = li; hipLaunchKernelGGL(hybrid_fwd, dim3(grid), dim3(NWAVES * 64), LDS_BYTES, stream, a); }
    }
}
```

```cpp
#include <hip/hip_runtime.h>
#include <cstdio>
#include <cstdint>

#ifndef MK_N_LAUNCHES
#define MK_N_LAUNCHES 1
#endif

namespace pg8 {
#define PG8_LAS __attribute__((address_space(3)))
typedef unsigned short bf16_t;
typedef short bf16x8 __attribute__((ext_vector_type(8)));
typedef float f32x4 __attribute__((ext_vector_type(4)));
typedef unsigned u32x4 __attribute__((ext_vector_type(4)));
constexpr int BM = 256, BK = 64, HALF = 128, HTB = HALF * BK * 2  , STAGE_BYTES = 8 * HTB, NXCD = 8, WGM = 8;

__host__ __device__ __forceinline__ int lds_byte(int r, int c) { const int st = (r >> 4) * 2 + (c >> 5), rr = r & 15, cc = c & 31, ob = rr * 64 + cc * 2; return st * 1024 + (ob ^ (((ob >> 9) & 1) << 5)); }
__host__ __device__ __forceinline__ void stage_rc(int b, int& R, int& C) { const int st = b / 1024, sb = b % 1024, swz = sb ^ (((sb >> 9) & 1) << 5); R = (st >> 1) * 16 + swz / 64; C = (st & 1) * 32 + (swz % 64) / 2; }
__host__ __device__ __forceinline__ int perm32(int rho) { const int n = rho >> 4, i = rho & 15; return 8 * (i >> 2) + 4 * n + (i & 3); }

struct Unit { int pm, pn; };
struct Gemm { const bf16_t* A; const bf16_t* Bt; int M, N, K; };

__host__ __device__ __forceinline__ int xcd_remap(int wgid, int nwg) { const int q = nwg / NXCD, r = nwg % NXCD, xcd = wgid % NXCD, off = wgid / NXCD; return (xcd < r ? xcd * (q + 1) : r * (q + 1) + (xcd - r) * q) + off; }

struct StaticOrder {
    int nM, nN, nwg, G, c;
    __host__ __device__ void init(int M, int N, int G_, int c_) { nM = M / BM; nN = N / BM; nwg = nM * nN; G = G_; c = c_; }
    __host__ __device__ bool next(int i, Unit& u) const {
        const long L = (long)i * G + c; if (L >= nwg) return false;
        const int wgid = xcd_remap((int)L, nwg);
        const int nig = WGM * nN, gid = wgid / nig, fm = gid * WGM, gsz = (nM - fm) < WGM ? (nM - fm) : WGM;
        u.pm = fm + ((wgid % nig) % gsz); u.pn = (wgid % nig) / gsz; return true;
    }
};
struct BranchOrder {
    StaticOrder S;
    __device__ bool next(int i, Unit& u) const { if (i >= 2) return false; if (!S.next(0, u)) return false; if (i == 1) { u.pm += 64; u.pn += 4; } return true; }
};
struct MoeOrder {
    int nwg, G, c; const PG8_LAS int* tp;
    __device__ bool next(int i, Unit& u) const {
        const long L = (long)i * G + c; if (L >= nwg) return false;
        const int wgid = xcd_remap((int)L, nwg); const int mt = wgid >> 2, nt = wgid & 3; int e = 0;
#pragma unroll
        for (int j = 1; j < 16; ++j) e += (mt >= tp[j]) ? 1 : 0;
        u.pm = mt; u.pn = e * 4 + nt; return true;
    }
};

__device__ __forceinline__ unsigned cvt_pk_bf16(float lo, float hi) { typedef float f2_ __attribute__((ext_vector_type(2))); typedef __bf16 b2_ __attribute__((ext_vector_type(2))); f2_ v = {lo, hi}; return __builtin_bit_cast(unsigned, __builtin_convertvector(v, b2_)); }
__device__ __forceinline__ float bf_lo(unsigned u) { return __uint_as_float(u << 16); }
__device__ __forceinline__ float bf_hi(unsigned u) { return __uint_as_float(u & 0xffff0000u); }
template <int CTRL> __device__ __forceinline__ float dpp_f(float v) { return __builtin_bit_cast(float, __builtin_amdgcn_update_dpp(0, __builtin_bit_cast(int, v), CTRL, 0xF, 0xF, true)); }
__device__ __forceinline__ float sigmoidf_(float x) { return __builtin_amdgcn_rcpf(1.0f + __expf(-x)); }


struct EpiProj {
    static constexpr bool PERM = true, AFTER_DRAIN = false;
    bf16_t *Qs, *Ks, *Vs, *Qh, *Kh, *Vh, *Gh, *gsb, *ghg; float* logf; float *emid, *elm, *dec; const float* lbl;
    __device__ __forceinline__ bool keep(const Unit&) const { return false; }
    __device__ __forceinline__ void operator()(f32x4 (&acc)[2][2][4][2], const Unit& u, int wr, int wc, int fr, int fq) const {
        const int colt = u.pn * BM, grp = colt >> 9;
        const int row0 = u.pm * BM + wr * 64 + fr;
        int act = 0, pitch = 512, cb = (colt & 511) + wc * 32 + 8 * fq; bf16_t* dst = Qs;
        if (grp == 1) dst = Ks; else if (grp == 2) dst = Vs; else if (grp == 3) { dst = Qh; act = 1; } else if (grp == 4) { dst = Kh; act = 3; } else if (grp == 5) dst = Vh;
        else if (grp == 6) { dst = Gh; act = 1; } else if (grp == 7 || grp == 8) { dst = gsb; act = 2; pitch = 1024; cb = (colt - 3584) + wc * 32 + 8 * fq; }
        else if (grp >= 9) { dst = ghg; act = 2; pitch = 1024; cb = (colt - 4608) + wc * 32 + 8 * fq; }
        if (act == 2) {
            const int gc = ((colt - 3584) >> 8) * 128 + wc * 32 + 8 * fq;
#pragma unroll
            for (int ai = 0; ai < 2; ++ai)
#pragma unroll
                for (int m = 0; m < 4; ++m) { const size_t off = (size_t)(row0 + ai * HALF + m * 16) * 1024 + gc; float rr[8], ss[8];
#pragma unroll
                    for (int j = 0; j < 8; ++j) { const float a = sigmoidf_(acc[ai][0][m][j >> 2][j & 3]), b = fmaxf(sigmoidf_(acc[ai][1][m][j >> 2][j & 3]), 1e-30f); ss[j] = b; rr[j] = a * __builtin_amdgcn_rcpf(b); }
                    u32x4 w; w.x = cvt_pk_bf16(rr[0], rr[1]); w.y = cvt_pk_bf16(rr[2], rr[3]); w.z = cvt_pk_bf16(rr[4], rr[5]); w.w = cvt_pk_bf16(rr[6], rr[7]);
                    *(u32x4*)(gsb + off) = w;
                    u32x4 w2; w2.x = cvt_pk_bf16(ss[0], ss[1]); w2.y = cvt_pk_bf16(ss[2], ss[3]); w2.z = cvt_pk_bf16(ss[4], ss[5]); w2.w = cvt_pk_bf16(ss[6], ss[7]);
                    *(u32x4*)(ghg + off) = w2; }
            return;
        }
        float lb[2][8];
        if (act == 3) {
#pragma unroll
            for (int bj = 0; bj < 2; ++bj)
#pragma unroll
                for (int j = 0; j < 8; ++j) { const int c = cb + bj * HALF + j; lb[bj][j] = __builtin_amdgcn_rcpf(1.0f + __expf(lbl[512 + c] - lbl[c])); }
        }
#pragma unroll
        for (int ai = 0; ai < 2; ++ai)
#pragma unroll
            for (int m = 0; m < 4; ++m) { const size_t row = (size_t)(row0 + ai * HALF + m * 16);
#pragma unroll
                for (int bj = 0; bj < 2; ++bj) {
                    float v[8]; { const f32x4 a = acc[ai][bj][m][0], b = acc[ai][bj][m][1]; v[0] = a[0]; v[1] = a[1]; v[2] = a[2]; v[3] = a[3]; v[4] = b[0]; v[5] = b[1]; v[6] = b[2]; v[7] = b[3]; }
                    if (act == 1) {
#pragma unroll
                        for (int j = 0; j < 8; ++j) v[j] = v[j] * sigmoidf_(v[j]);
                    } else if (act == 3) {
#pragma unroll
                        for (int j = 0; j < 8; ++j) { const float l = lb[bj][j], sg = sigmoidf_(v[j]); const float f = l + (1.0f - l) * sg; const float lg = __logf(f); v[j] = 1.0f - f;
                            acc[ai][bj][m][j >> 2][j & 3] = lg; }
                    }
                    u32x4 w; w.x = cvt_pk_bf16(v[0], v[1]); w.y = cvt_pk_bf16(v[2], v[3]); w.z = cvt_pk_bf16(v[4], v[5]); w.w = cvt_pk_bf16(v[6], v[7]);
                    *(u32x4*)(dst + row * pitch + cb + bj * HALF) = w;
                } }
        if (act == 3) {
#pragma unroll
            for (int ai = 0; ai < 2; ++ai)
#pragma unroll
                for (int bj = 0; bj < 2; ++bj) { float mid[8], last[8];
#pragma unroll
                    for (int j = 0; j < 8; ++j) { float carry = 0.f;
#pragma unroll
                        for (int m = 0; m < 4; ++m) { float x = acc[ai][bj][m][j >> 2][j & 3];
                            x += dpp_f<0x111>(x); x += dpp_f<0x112>(x); x += dpp_f<0x114>(x); x += dpp_f<0x118>(x);
                            x += carry; acc[ai][bj][m][j >> 2][j & 3] = x; carry = dpp_f<0x15F>(x); if (m == 1) mid[j] = carry; }
                        last[j] = carry; }
#pragma unroll
                    for (int m = 0; m < 4; ++m) { bf16_t* kq = Kh + (size_t)(row0 + ai * HALF + m * 16) * 512 + cb + bj * HALF;
                        const u32x4 kw = *(const u32x4*)kq; float bb[8] = {bf_lo(kw.x), bf_hi(kw.x), bf_lo(kw.y), bf_hi(kw.y), bf_lo(kw.z), bf_hi(kw.z), bf_lo(kw.w), bf_hi(kw.w)};
#pragma unroll
                        for (int j = 0; j < 8; ++j) bb[j] *= __expf(mid[j] - acc[ai][bj][m][j >> 2][j & 3]);
                        u32x4 w; w.x = cvt_pk_bf16(bb[0], bb[1]); w.y = cvt_pk_bf16(bb[2], bb[3]); w.z = cvt_pk_bf16(bb[4], bb[5]); w.w = cvt_pk_bf16(bb[6], bb[7]);
                        *(u32x4*)kq = w;
                        float ea[8];
#pragma unroll
                        for (int j = 0; j < 8; ++j) ea[j] = __expf(acc[ai][bj][m][j >> 2][j & 3] - mid[j]);
                        u32x4 w2; w2.x = cvt_pk_bf16(ea[0], ea[1]); w2.y = cvt_pk_bf16(ea[2], ea[3]); w2.z = cvt_pk_bf16(ea[4], ea[5]); w2.w = cvt_pk_bf16(ea[6], ea[7]);
                        *(u32x4*)((bf16_t*)logf + (size_t)(row0 + ai * HALF + m * 16) * 512 + cb + bj * HALF) = w2; }
                    if (fr == 15) { const size_t vo = (size_t)(4 * u.pm + 2 * ai + wr) * 512 + cb + bj * HALF;
                        *(f32x4*)(emid + vo) = (f32x4){__expf(mid[0]), __expf(mid[1]), __expf(mid[2]), __expf(mid[3])}; *(f32x4*)(emid + vo + 4) = (f32x4){__expf(mid[4]), __expf(mid[5]), __expf(mid[6]), __expf(mid[7])};
                        *(f32x4*)(elm + vo) = (f32x4){__expf(last[0] - mid[0]), __expf(last[1] - mid[1]), __expf(last[2] - mid[2]), __expf(last[3] - mid[3])};
                        *(f32x4*)(elm + vo + 4) = (f32x4){__expf(last[4] - mid[4]), __expf(last[5] - mid[5]), __expf(last[6] - mid[6]), __expf(last[7] - mid[7])};
                        *(f32x4*)(dec + vo) = (f32x4){__expf(last[0]), __expf(last[1]), __expf(last[2]), __expf(last[3])}; *(f32x4*)(dec + vo + 4) = (f32x4){__expf(last[4]), __expf(last[5]), __expf(last[6]), __expf(last[7])}; } }
        }
    }
};

struct EpiBranch {
    static constexpr bool PERM = true, AFTER_DRAIN = false;
    const bf16_t *gsb, *ghg; bf16_t* out;
    __device__ __forceinline__ bool keep(const Unit& u) const { return u.pn < 4; }
    __device__ __forceinline__ void operator()(f32x4 (&acc)[2][2][4][2], const Unit& u, int wr, int wc, int fr, int fq) const {
        const bool first = u.pn < 4; const int pn = u.pn & 3, pm = u.pm & 63;
        const int row0 = pm * BM + wr * 64 + fr, col0 = pn * BM + wc * 32 + 8 * fq;
        const bf16_t* gp = first ? gsb : ghg;
#pragma unroll
        for (int ai = 0; ai < 2; ++ai)
#pragma unroll
            for (int m = 0; m < 4; ++m) { const size_t off = (size_t)(row0 + ai * HALF + m * 16) * 1024 + col0;
#pragma unroll
                for (int bj = 0; bj < 2; ++bj) {
                    const u32x4 gh = *(const u32x4*)(gp + off + bj * HALF);
                    const float s[8] = {bf_lo(gh.x), bf_hi(gh.x), bf_lo(gh.y), bf_hi(gh.y), bf_lo(gh.z), bf_hi(gh.z), bf_lo(gh.w), bf_hi(gh.w)};
                    f32x4 a = acc[ai][bj][m][0], b = acc[ai][bj][m][1];
                    a[0] *= s[0]; a[1] *= s[1]; a[2] *= s[2]; a[3] *= s[3]; b[0] *= s[4]; b[1] *= s[5]; b[2] *= s[6]; b[3] *= s[7];
                    acc[ai][bj][m][0] = a; acc[ai][bj][m][1] = b;
                    if (!first) { u32x4 w; w.x = cvt_pk_bf16(a[0], a[1]); w.y = cvt_pk_bf16(a[2], a[3]); w.z = cvt_pk_bf16(b[0], b[1]); w.w = cvt_pk_bf16(b[2], b[3]);
                        *(u32x4*)(out + off + bj * HALF) = w; }
                } }
    }
};

struct EpiResBf16 {
    static constexpr bool PERM = true, AFTER_DRAIN = false;
    const float* base; bf16_t* out;
    __device__ __forceinline__ bool keep(const Unit&) const { return false; }
    __device__ __forceinline__ void operator()(f32x4 (&acc)[2][2][4][2], const Unit& u, int wr, int wc, int fr, int fq) const {
        const int row0 = u.pm * BM + wr * 64 + fr, col0 = u.pn * BM + wc * 32 + 8 * fq;
#pragma unroll
        for (int ai = 0; ai < 2; ++ai)
#pragma unroll
            for (int m = 0; m < 4; ++m) { const size_t off = (size_t)(row0 + ai * HALF + m * 16) * 1024 + col0;
#pragma unroll
                for (int bj = 0; bj < 2; ++bj) { const f32x4 x0 = *(const f32x4*)(base + off + bj * HALF) + acc[ai][bj][m][0], x1 = *(const f32x4*)(base + off + bj * HALF + 4) + acc[ai][bj][m][1];
                    u32x4 w; w.x = cvt_pk_bf16(x0[0], x0[1]); w.y = cvt_pk_bf16(x0[2], x0[3]); w.z = cvt_pk_bf16(x1[0], x1[1]); w.w = cvt_pk_bf16(x1[2], x1[3]);
                    *(u32x4*)(out + off + bj * HALF) = w; } }
    }
};

struct EpiMoeUp {
    static constexpr bool PERM = true, AFTER_DRAIN = false;
    bf16_t* H;
    __device__ __forceinline__ bool keep(const Unit&) const { return false; }
    __device__ __forceinline__ void operator()(f32x4 (&acc)[2][2][4][2], const Unit& u, int wr, int wc, int fr, int fq) const {
        const int nt = u.pn & 3; const int row0 = u.pm * BM + wr * 64 + fr, col0 = nt * 128 + wc * 32 + 8 * fq;
#pragma unroll
        for (int ai = 0; ai < 2; ++ai)
#pragma unroll
            for (int m = 0; m < 4; ++m) { const size_t off = (size_t)(row0 + ai * HALF + m * 16) * 512 + col0;
                float v[8];
#pragma unroll
                for (int n = 0; n < 2; ++n)
#pragma unroll
                    for (int j = 0; j < 4; ++j) { const float g = acc[ai][0][m][n][j], up = acc[ai][1][m][n][j]; v[n * 4 + j] = g * sigmoidf_(g) * up; }
                u32x4 w; w.x = cvt_pk_bf16(v[0], v[1]); w.y = cvt_pk_bf16(v[2], v[3]); w.z = cvt_pk_bf16(v[4], v[5]); w.w = cvt_pk_bf16(v[6], v[7]);
                *(u32x4*)(H + off) = w; }
    }
};

struct EpiMoeDown {
    static constexpr bool PERM = true, AFTER_DRAIN = false;
    const int* rowtok; const float* roww; bf16_t* Y0; bf16_t* Y1;
    __device__ __forceinline__ bool keep(const Unit&) const { return false; }
    __device__ __forceinline__ void operator()(f32x4 (&acc)[2][2][4][2], const Unit& u, int wr, int wc, int fr, int fq) const {
        const int nt = u.pn & 3; const int row0 = u.pm * BM + wr * 64 + fr, col0 = nt * BM + wc * 32 + 8 * fq;
#pragma unroll
        for (int ai = 0; ai < 2; ++ai)
#pragma unroll
            for (int m = 0; m < 4; ++m) { const int prow = row0 + ai * HALF + m * 16; const int ts = rowtok[prow]; const float w = roww[prow];
                if (ts >= 0) { bf16_t* yp = ((ts & 1) ? Y1 : Y0) + (size_t)(ts >> 1) * 1024 + col0;
#pragma unroll
                    for (int bj = 0; bj < 2; ++bj) { const f32x4 a = acc[ai][bj][m][0] * w, b = acc[ai][bj][m][1] * w;
                        u32x4 o; o.x = cvt_pk_bf16(a[0], a[1]); o.y = cvt_pk_bf16(a[2], a[3]); o.z = cvt_pk_bf16(b[0], b[1]); o.w = cvt_pk_bf16(b[2], b[3]);
                        *(u32x4*)(yp + bj * HALF) = o; } } }
    }
};

template <class Epi, class Sched, bool ALIGN_EPI = false, bool SP2 = false, bool GATHER = false>
__device__ __forceinline__ void gemm_phase(PG8_LAS unsigned char* lds, const Gemm g, const Sched& S, const Epi& E, const int* rowidx = nullptr) {
    static_assert(!GATHER || SP2, "GATHER is implemented for the SP2 loop");
    int tid_ = threadIdx.x; asm volatile("" : "+v"(tid_));
    const int tid = tid_, wid = __builtin_amdgcn_readfirstlane(tid >> 6), lane = tid & 63, wr = wid >> 2, wc = wid & 3, fr = lane & 15, fq = lane >> 4;
    const int K = g.K, nt = K / BK;
    unsigned voffA[2], voffB[2]; int rslot[2] = {0, 0}; unsigned coff[2] = {0u, 0u};
#pragma unroll
    for (int i = 0; i < 2; ++i) { int R, C; stage_rc(tid * 16 + i * 8192, R, C); const int Rb = Epi::PERM ? ((R & ~31) + perm32(R & 31)) : R;
        voffA[i] = (unsigned)(R * K + C) * 2u; voffB[i] = (unsigned)(Rb * K + C) * 2u; if constexpr (GATHER) { rslot[i] = R; coff[i] = (unsigned)C * 2u; } }
    const size_t kstep = (size_t)(BK * 2);
    const size_t hstep = (size_t)HALF * K * 2;
    const size_t tstep = 2 * hstep;
    const unsigned ldsw = (unsigned)wid * 1024u;
    const int aoff = lds_byte(wr * 64 + fr, fq * 8), boff = lds_byte(wc * 32 + fr, fq * 8);
#define PG8_SA(b, h) (((b) * 2 + (h)) * HTB)
#define PG8_SB(b, h) ((4 + (b) * 2 + (h)) * HTB)
#define PG8_STAGE(bufoff, gbase, voff) do { _Pragma("unroll") for (int _i = 0; _i < 2; ++_i) \
        __builtin_amdgcn_global_load_lds((const unsigned*)((const char*)(gbase) + (voff)[_i]), (PG8_LAS unsigned*)(lds + (bufoff) + ldsw + _i * 8192), 16, 0, 0); } while (0)
#define PG8_LDA(dst, b, h) do { _Pragma("unroll") for (int m = 0; m < 4; ++m) _Pragma("unroll") for (int k = 0; k < 2; ++k) dst[m][k] = *(const PG8_LAS bf16x8*)(lds + PG8_SA(b, h) + aoff + m * 2048 + k * 1024); } while (0)
#define PG8_LDB(dst, b, h) do { _Pragma("unroll") for (int n = 0; n < 2; ++n) _Pragma("unroll") for (int k = 0; k < 2; ++k) dst[n][k] = *(const PG8_LAS bf16x8*)(lds + PG8_SB(b, h) + boff + n * 2048 + k * 1024); } while (0)
#define PG8_MMA(ai, bj, At, Bt) do { __builtin_amdgcn_s_setprio(1); _Pragma("unroll") for (int m = 0; m < 4; ++m) _Pragma("unroll") for (int n = 0; n < 2; ++n) _Pragma("unroll") for (int k = 0; k < 2; ++k) \
        acc[ai][bj][m][n] = __builtin_amdgcn_mfma_f32_16x16x32_bf16(Bt[n][k], At[m][k], acc[ai][bj][m][n], 0, 0, 0); __builtin_amdgcn_s_setprio(0); } while (0)
#define PG8_WAIT_V(n) asm volatile("s_waitcnt vmcnt(" #n ")" ::: "memory")
#define PG8_WAIT_L(n) asm volatile("s_waitcnt lgkmcnt(" #n ")" ::: "memory")
#define PG8_BAR __builtin_amdgcn_s_barrier()
#define PG8_SCHED __builtin_amdgcn_sched_barrier(0)
    Unit cur, nxt; int ui = 0;
    if (!S.next(0, cur)) return;
    f32x4 acc[2][2][4][2];
#pragma unroll
    for (int a = 0; a < 2; ++a)
#pragma unroll
        for (int b = 0; b < 2; ++b)
#pragma unroll
            for (int m = 0; m < 4; ++m)
#pragma unroll
                for (int n = 0; n < 2; ++n) acc[a][b][m][n] = (f32x4){0.f, 0.f, 0.f, 0.f};
    bf16x8 At[4][2], B0[2][2], B1[2][2];
    unsigned gC[2][2], gN[2][2];
#define PG8_ROWOFFS(dst, U) do { _Pragma("unroll") for (int h_ = 0; h_ < 2; ++h_) _Pragma("unroll") for (int i_ = 0; i_ < 2; ++i_) { \
        if constexpr (GATHER) { const int t_ = rowidx[(U).pm * BM + h_ * HALF + rslot[i_]]; dst[h_][i_] = (unsigned)((t_ < 0 ? 0 : (t_ >> 1)) * K) * 2u + coff[i_]; } \
        else dst[h_][i_] = voffA[i_] + (unsigned)(h_ * hstep); } } while (0)
    PG8_ROWOFFS(gC, cur);
#pragma unroll
    for (int h_ = 0; h_ < 2; ++h_)
#pragma unroll
        for (int i_ = 0; i_ < 2; ++i_) gN[h_][i_] = gC[h_][i_];
    const char* cA = (const char*)g.A + (GATHER ? (size_t)0 : (size_t)cur.pm * tstep); const char* cB = (const char*)g.Bt + (size_t)cur.pn * tstep;
    if constexpr (SP2) {
        PG8_STAGE(PG8_SB(0, 0), cB, voffB); PG8_STAGE(PG8_SB(0, 1), cB + hstep, voffB); PG8_STAGE(PG8_SA(0, 0), cA, gC[0]); PG8_STAGE(PG8_SA(0, 1), cA, gC[1]);
        if (wr == 1) PG8_BAR;
        PG8_WAIT_V(2); PG8_BAR;
        PG8_STAGE(PG8_SB(1, 0), cB + kstep, voffB); PG8_STAGE(PG8_SA(1, 0), cA + kstep, gC[0]); PG8_STAGE(PG8_SB(1, 1), cB + hstep + kstep, voffB);
        PG8_WAIT_V(6); PG8_BAR;
    } else {
        PG8_STAGE(PG8_SB(0, 0), cB, voffB); PG8_STAGE(PG8_SA(0, 0), cA, voffA); PG8_STAGE(PG8_SB(0, 1), cB + hstep, voffB); PG8_STAGE(PG8_SA(0, 1), cA + hstep, voffA);
        if (wr == 1) PG8_BAR;
        PG8_WAIT_V(4); PG8_BAR;
        PG8_STAGE(PG8_SB(1, 0), cB + kstep, voffB); PG8_STAGE(PG8_SA(1, 0), cA + kstep, voffA); PG8_STAGE(PG8_SB(1, 1), cB + hstep + kstep, voffB);
        PG8_WAIT_V(6); PG8_BAR;
    }
    for (;;) {
        const bool has_next = S.next(ui + 1, nxt);
        const char* nA = (has_next && !GATHER) ? (const char*)g.A + (size_t)nxt.pm * tstep : cA; const char* nB = has_next ? (const char*)g.Bt + (size_t)nxt.pn * tstep : cB;
        if (has_next) { PG8_ROWOFFS(gN, nxt); }
        for (int t = 0; t < nt; t += 2) {
            const bool last = (t == nt - 2);
            const char* a1 = cA + (size_t)(t + 1) * kstep;
            const char* a2 = last ? nA : cA + (size_t)(t + 2) * kstep; const char* b2 = last ? nB : cB + (size_t)(t + 2) * kstep;
            const char* a3 = a2 + kstep; const char* b3 = b2 + kstep;
            if constexpr (SP2) {
            unsigned g2[2][2];
#pragma unroll
            for (int h_ = 0; h_ < 2; ++h_)
#pragma unroll
                for (int i_ = 0; i_ < 2; ++i_) g2[h_][i_] = last ? gN[h_][i_] : gC[h_][i_];
            PG8_LDB(B0, 0, 0); PG8_LDB(B1, 0, 1); PG8_SCHED; PG8_LDA(At, 0, 0); PG8_STAGE(PG8_SA(1, 1), a1, gC[1]);
            PG8_WAIT_V(8); PG8_WAIT_L(0); PG8_BAR; PG8_MMA(0, 0, At, B0); PG8_MMA(0, 1, At, B1); PG8_BAR; PG8_SCHED;
            PG8_LDA(At, 0, 1); PG8_STAGE(PG8_SB(0, 0), b2, voffB); PG8_STAGE(PG8_SB(0, 1), b2 + hstep, voffB); PG8_STAGE(PG8_SA(0, 0), a2, g2[0]);
            PG8_WAIT_V(8); PG8_WAIT_L(0); PG8_BAR; PG8_MMA(1, 0, At, B0); PG8_MMA(1, 1, At, B1); PG8_BAR; PG8_SCHED;
            PG8_LDB(B0, 1, 0); PG8_LDB(B1, 1, 1); PG8_SCHED; PG8_LDA(At, 1, 0); PG8_STAGE(PG8_SA(0, 1), a2, g2[1]);
            PG8_WAIT_V(8); PG8_WAIT_L(0); PG8_BAR; PG8_MMA(0, 0, At, B0); PG8_MMA(0, 1, At, B1); PG8_BAR; PG8_SCHED;
            PG8_LDA(At, 1, 1); PG8_STAGE(PG8_SB(1, 0), b3, voffB); PG8_STAGE(PG8_SB(1, 1), b3 + hstep, voffB); PG8_STAGE(PG8_SA(1, 0), a3, g2[0]);
            PG8_WAIT_V(8); PG8_WAIT_L(0); PG8_BAR; PG8_MMA(1, 0, At, B0); PG8_MMA(1, 1, At, B1); PG8_BAR; PG8_SCHED;
            } else {
            PG8_LDB(B0, 0, 0); PG8_SCHED; PG8_LDA(At, 0, 0); PG8_STAGE(PG8_SA(1, 1), a1 + hstep, voffA);
            PG8_WAIT_L(8); PG8_BAR; PG8_WAIT_L(0); PG8_MMA(0, 0, At, B0); PG8_BAR; PG8_SCHED;
            PG8_LDB(B1, 0, 1); PG8_STAGE(PG8_SB(0, 0), b2, voffB);
            PG8_BAR; PG8_WAIT_L(0); PG8_MMA(0, 1, At, B1); PG8_BAR;
            PG8_LDA(At, 0, 1); PG8_STAGE(PG8_SA(0, 0), a2, voffA);
            PG8_BAR; PG8_WAIT_L(0); PG8_MMA(1, 0, At, B0); PG8_BAR; PG8_SCHED;
            PG8_STAGE(PG8_SB(0, 1), b2 + hstep, voffB);
            PG8_WAIT_V(6); PG8_BAR; PG8_MMA(1, 1, At, B1); PG8_BAR;
            PG8_LDB(B0, 1, 0); PG8_SCHED; PG8_LDA(At, 1, 0); PG8_STAGE(PG8_SA(0, 1), a2 + hstep, voffA);
            PG8_WAIT_L(8); PG8_BAR; PG8_WAIT_L(0); PG8_MMA(0, 0, At, B0); PG8_BAR; PG8_SCHED;
            PG8_LDB(B1, 1, 1); PG8_STAGE(PG8_SB(1, 0), b3, voffB);
            PG8_BAR; PG8_WAIT_L(0); PG8_MMA(0, 1, At, B1); PG8_BAR;
            PG8_LDA(At, 1, 1); PG8_STAGE(PG8_SA(1, 0), a3, voffA);
            PG8_BAR; PG8_WAIT_L(0); PG8_MMA(1, 0, At, B0); PG8_BAR; PG8_SCHED;
            PG8_STAGE(PG8_SB(1, 1), b3 + hstep, voffB);
            PG8_WAIT_V(6); PG8_BAR; PG8_MMA(1, 1, At, B1); PG8_BAR;
            }
        }
        if constexpr (ALIGN_EPI) { if (wr == 0) PG8_BAR; }
        E(acc, cur, wr, wc, fr, fq);
        if (!has_next) break;
        if (!E.keep(cur)) {
#pragma unroll
        for (int a = 0; a < 2; ++a)
#pragma unroll
            for (int b = 0; b < 2; ++b)
#pragma unroll
                for (int m = 0; m < 4; ++m)
#pragma unroll
                    for (int n = 0; n < 2; ++n) acc[a][b][m][n] = (f32x4){0.f, 0.f, 0.f, 0.f};
        }
        cur = nxt; cA = nA; cB = nB; ++ui;
#pragma unroll
        for (int h_ = 0; h_ < 2; ++h_)
#pragma unroll
            for (int i_ = 0; i_ < 2; ++i_) gC[h_][i_] = gN[h_][i_];
        if constexpr (ALIGN_EPI) { if (wr == 1) PG8_BAR; }
    }
    PG8_WAIT_V(0);
    if constexpr (!ALIGN_EPI) { if (wr == 0) PG8_BAR; }
    PG8_BAR;
#undef PG8_ROWOFFS
#undef PG8_SA
#undef PG8_SB
#undef PG8_STAGE
#undef PG8_LDA
#undef PG8_LDB
#undef PG8_MMA
#undef PG8_WAIT_V
#undef PG8_WAIT_L
#undef PG8_BAR
#undef PG8_SCHED
}
}

#ifndef PG8_SP2
#define PG8_SP2 true
#endif
#ifndef PG8_ALIGN
#define PG8_ALIGN true
#endif

constexpr int NWAVES = 8;
constexpr int N_LAUNCHES = MK_N_LAUNCHES;
constexpr int N_PHASES = 12;
constexpr int BATCH = 2, SEQ = 8192, D = 1024, M = BATCH * SEQ;
constexpr int HW = 512;
constexpr int IN_COLS = 5632, NEXP = 16, DEXP = 512;
constexpr float EPS = 1e-6f;
constexpr int MOE_ROWS = 36864;
constexpr float SB_EXIT = 30.0f;

constexpr size_t MiB = 1u << 20;
constexpr size_t WS_CTL = 0, CTL_ZERO_BYTES = 1 * MiB;
constexpr size_t WS_SMALL = 1 * MiB;
constexpr size_t WS_WIN = 4 * MiB;
constexpr size_t WS_WBR = 15 * MiB;
constexpr size_t WS_WOUT = 17 * MiB;
constexpr size_t WS_W1 = 19 * MiB;
constexpr size_t WS_WD = 51 * MiB;
constexpr size_t WS_XN = 67 * MiB;
constexpr size_t WS_QS = 99 * MiB;
constexpr size_t WS_KS = 115 * MiB, WS_VS = 131 * MiB, WS_QH = 147 * MiB, WS_KH = 163 * MiB, WS_VH = 179 * MiB;
constexpr size_t WS_SIN = 83 * MiB;
constexpr size_t WS_LOGF = 195 * MiB;
constexpr size_t WS_GH = 227 * MiB;
constexpr size_t WS_TS = 99 * MiB;
constexpr size_t WS_X1 = 131 * MiB;
constexpr size_t WS_H = 171 * MiB;
constexpr size_t WS_Y1 = 207 * MiB;
constexpr size_t WS_END = 256 * MiB;
static_assert(WS_GH + (size_t)M * HW * 2 <= WS_END && WS_Y1 + (size_t)M * D * 2 <= WS_END && WS_TS + (size_t)M * D * 2 <= WS_X1 && WS_X1 + (size_t)M * D * 2 <= WS_H && WS_H + (size_t)MOE_ROWS * DEXP * 2 <= WS_Y1, "ws map");
constexpr size_t SM_HIST = 0;
constexpr size_t SM_META = 16384;
constexpr size_t SM_TOKE = 32768;
constexpr size_t SM_TOKW = SM_TOKE + (size_t)M * 8;
constexpr size_t SM_RSTD = SM_TOKW + (size_t)M * 8;
constexpr size_t SM_ROWTOK = SM_RSTD + (size_t)M * 4;
constexpr size_t SM_ROWW = SM_ROWTOK + (size_t)MOE_ROWS * 4;
constexpr size_t SM_DEC = SM_ROWW + (size_t)MOE_ROWS * 4;
constexpr size_t SM_EMID = SM_DEC + 256 * 512 * 4, SM_ELM = SM_EMID + 256 * 512 * 4;
static_assert(WS_SMALL + SM_ELM + 256 * 512 * 4 <= WS_WIN, "small arrays");
constexpr int CW_BAR = 4096;

constexpr int RING_BYTES = 131072;
constexpr int LDSCTL_OFF = 143360, MISC_OFF = LDSCTL_OFF + 320;
constexpr int LDS_BYTES = 147456;

#define GAS __attribute__((address_space(1)))
#define LAS __attribute__((address_space(3)))
typedef unsigned short bf16;
typedef unsigned v4u __attribute__((ext_vector_type(4)));
typedef unsigned v2u __attribute__((ext_vector_type(2)));
typedef float f32x4 __attribute__((ext_vector_type(4)));
typedef GAS unsigned gu32;
#define RLX_AGENT __ATOMIC_RELAXED, __HIP_MEMORY_SCOPE_AGENT
#define LDS_WAIT() asm volatile("s_waitcnt lgkmcnt(0)" ::: "memory")
#define VM_WAIT() asm volatile("s_waitcnt vmcnt(0)" ::: "memory")
__device__ __forceinline__ unsigned f2bf(float f) { unsigned u = __builtin_bit_cast(unsigned, f); return (u + 0x7fffu + ((u >> 16) & 1u)) >> 16; }
__device__ __forceinline__ unsigned pk2(float lo, float hi) { return f2bf(lo) | (f2bf(hi) << 16); }
__device__ __forceinline__ float bf2f(bf16 v) { return __uint_as_float((unsigned)v << 16); }
__device__ __forceinline__ float blo(unsigned u) { return __uint_as_float(u << 16); }
__device__ __forceinline__ float bhi(unsigned u) { return __uint_as_float(u & 0xffff0000u); }

#define XB_TMO      128
#define XB_XCNT(j)  (256  + 64 * (j))
#define XB_XSUB(j)  (1280 + 64 * (j))
#define XB_XGEN(j)  (2304 + 64 * (j))
#define XB_TOP      3328
#define XB_TOPGEN   3392
#define XB_EXIT     3456
#define XCD_BAR_WORDS 3520
__device__ unsigned g_grid_barrier[XCD_BAR_WORDS];
#define XB_SPIN_CAP (1u << 18)
__device__ __forceinline__ unsigned xb_ld(unsigned* p)              { return __hip_atomic_load(p, __ATOMIC_RELAXED, __HIP_MEMORY_SCOPE_AGENT); }
__device__ __forceinline__ unsigned xb_add(unsigned* p, unsigned v) { return __hip_atomic_fetch_add(p, v, __ATOMIC_RELAXED, __HIP_MEMORY_SCOPE_AGENT); }
__device__ __forceinline__ unsigned xb_xcc_id() { return (unsigned)__builtin_amdgcn_s_getreg((3 << 11) | 20) & 0xFu; }
#define XB_SPIN(cond, bar) do { unsigned _sp = 0; while (cond) { __builtin_amdgcn_s_sleep(1); \
    if ((++_sp & 255u) == 0u) { if (xb_ld(&(bar)[XB_TMO])) break; if (_sp > XB_SPIN_CAP) { atomicAdd(&(bar)[XB_TMO], 1u); break; } } } } while (0)
struct XcdBarrier { unsigned* bar; unsigned x; volatile LAS unsigned* st; };
__device__ __forceinline__ XcdBarrier xcd_barrier_post(unsigned* bar, volatile LAS unsigned* st) {
    XcdBarrier b; b.bar = bar; b.x = xb_xcc_id(); b.st = st;
    if (threadIdx.x == 0) (void)xb_add(&bar[XB_XCNT(b.x)], 1u);
    return b;
}
__device__ __forceinline__ void xcd_barrier_complete(unsigned* bar, unsigned x, unsigned& nloc, unsigned& nx) {
    const unsigned G = gridDim.x * gridDim.y * gridDim.z;
    unsigned sum, cnt, mine, sp = 0u;
    for (;;) {
        sum = 0u; cnt = 0u; mine = 0u;
#pragma unroll
        for (unsigned j = 0; j < 16; ++j) { const unsigned c = xb_ld(&bar[XB_XCNT(j)]); sum += c; cnt += (c > 0u) ? 1u : 0u; mine = (j == x) ? c : mine; }
        if (sum == G) break;
        __builtin_amdgcn_s_sleep(1);
        if ((++sp & 255u) == 0u) { if (xb_ld(&bar[XB_TMO])) break; if (sp > XB_SPIN_CAP) { atomicAdd(&bar[XB_TMO], 1u); break; } }
    }
    nloc = mine > 0u ? mine : 1u; nx = cnt > 0u ? cnt : 1u;
}
__device__ __forceinline__ void xcd_barrier(const XcdBarrier& b) {
    asm volatile("s_waitcnt vmcnt(0)" ::: "memory");
    __syncthreads();
    if (threadIdx.x == 0) {
        unsigned* bar = b.bar;
        __builtin_amdgcn_s_waitcnt(0);
        unsigned nloc = b.st[0], nx = b.st[1];
        if (nloc == 0u) { xcd_barrier_complete(bar, b.x, nloc, nx); b.st[0] = nloc; b.st[1] = nx; }
        const unsigned old = xb_add(&bar[XB_XSUB(b.x)], 1u);
        const unsigned gen = old / nloc;
        if (old + 1u == (gen + 1u) * nloc) {
            __builtin_amdgcn_fence(__ATOMIC_RELEASE, "agent");
            asm volatile("s_waitcnt vmcnt(0)" ::: "memory");
            const unsigned og = xb_add(&bar[XB_TOP], 1u);
            const unsigned tg = og / nx;
            if (og + 1u == (tg + 1u) * nx) xb_add(&bar[XB_TOPGEN], 1u);
            else XB_SPIN(xb_ld(&bar[XB_TOPGEN]) == tg, bar);
            __builtin_amdgcn_fence(__ATOMIC_ACQUIRE, "agent");
            xb_add(&bar[XB_XGEN(b.x)], 1u);
            asm volatile("s_waitcnt vmcnt(0)" ::: "memory");
        } else {
            XB_SPIN(xb_ld(&bar[XB_XGEN(b.x)]) == gen, bar);
            __builtin_amdgcn_fence(__ATOMIC_ACQUIRE, "agent");
            asm volatile("s_waitcnt vmcnt(0)" ::: "memory");
        }
    }
    __syncthreads();
}

struct Frame {
    LAS unsigned char* lds;
    volatile LAS unsigned* MISC;
    gu32* ctl;
    int tid, lane, wave;
    int vcu, G;
    unsigned char* ws;
    const float* x; float* out;
    const float *ln1_g, *w_in, *w_bsb, *w_bhg, *hg_norm_g, *lbl, *w_out, *ln2_g, *w_rg, *b_rg, *w_re, *b_re, *w_eg, *w_eu, *w_ed, *final_g;
    volatile LAS unsigned long long* PT;
};
__device__ __forceinline__ const float* fin(const Frame& F, int k) { const unsigned long long v = F.PT[k]; const unsigned lo = __builtin_amdgcn_readfirstlane((unsigned)v), hi = __builtin_amdgcn_readfirstlane((unsigned)(v >> 32)); return (const float*)(const GAS float*)(((unsigned long long)hi << 32) | lo); }
__device__ __forceinline__ float wave_sum(float v) {
#pragma unroll
    for (int o = 1; o < 64; o <<= 1) v += __shfl_xor(v, o);
    return v;
}

struct CvItem { const float* src; bf16* dst; int N, K; };
__device__ __forceinline__ void cv_load(const CvItem& c, f32x4 (&v)[8], int lane) {
    const GAS float* p = (const GAS float*)c.src + (size_t)(lane >> 3) * c.N + (lane & 7) * 4;
#pragma unroll
    for (int i = 0; i < 8; ++i) v[i] = *(const GAS f32x4*)(p + (size_t)(8 * i) * c.N);
}
__device__ __forceinline__ void cv_finish(const CvItem& c, const f32x4 (&v)[8], LAS float* scr, int lane) {
#pragma unroll
    for (int i = 0; i < 8; ++i) { LAS float* d = scr + ((lane >> 3) + 8 * i) * 33 + (lane & 7) * 4; d[0] = v[i].x; d[1] = v[i].y; d[2] = v[i].z; d[3] = v[i].w; }
    LDS_WAIT(); asm volatile("" ::: "memory");
    const int cc = lane & 7;
#pragma unroll
    for (int j = 0; j < 4; ++j) { const int n = (lane >> 3) + 8 * j; const LAS float* s = scr + (8 * cc) * 33 + n;
        v4u o; o.x = pk2(s[0 * 33], s[1 * 33]); o.y = pk2(s[2 * 33], s[3 * 33]); o.z = pk2(s[4 * 33], s[5 * 33]); o.w = pk2(s[6 * 33], s[7 * 33]);
        *(GAS v4u*)(c.dst + (size_t)n * c.K + 8 * cc) = o; }
    LDS_WAIT(); asm volatile("" ::: "memory");
}
constexpr int CV_IN = 16 * 176, CV_BR = 8 * 32, CV_OUT = 16 * 32, CV_G = 16 * 16 * 16, CV_D = 16 * 8 * 32;
constexpr int N_EARLY = CV_IN + 2 * CV_BR + CV_OUT, N_LATE = 2 * CV_G + CV_D;
__device__ __forceinline__ CvItem cv_decode(const Frame& F, int it) {
    bf16* WinT = (bf16*)(F.ws + WS_WIN); bf16* WbrT = (bf16*)(F.ws + WS_WBR); bf16* WoutT = (bf16*)(F.ws + WS_WOUT); bf16* W1 = (bf16*)(F.ws + WS_W1); bf16* WdT = (bf16*)(F.ws + WS_WD);
    int r = it;
    if (r < CV_IN) { const int kb = r / 176, nb = r % 176, n0 = nb * 32; int drow = n0;
        if (n0 >= 4608) { const int c = n0 - 4608; drow = 3584 + (c >> 7) * 256 + 128 + (c & 127); } else if (n0 >= 3584) { const int c = n0 - 3584; drow = 3584 + (c >> 7) * 256 + (c & 127); }
        return CvItem{F.w_in + (size_t)(64 * kb) * IN_COLS + n0, WinT + (size_t)drow * 1024 + 64 * kb, IN_COLS, 1024}; } r -= CV_IN;
    if (r < CV_BR) { const int kb = r / 32, nb = r % 32; return CvItem{F.w_bsb + (size_t)(64 * kb) * 1024 + nb * 32, WbrT + (size_t)(nb * 32) * 512 + 64 * kb, 1024, 512}; } r -= CV_BR;
    if (r < CV_BR) { const int kb = r / 32, nb = r % 32; return CvItem{F.w_bhg + (size_t)(64 * kb) * 1024 + nb * 32, WbrT + (size_t)(1024 + nb * 32) * 512 + 64 * kb, 1024, 512}; } r -= CV_BR;
    if (r < CV_OUT) { const int kb = r / 32, nb = r % 32; return CvItem{F.w_out + (size_t)(64 * kb) * 1024 + nb * 32, WoutT + (size_t)(nb * 32) * 1024 + 64 * kb, 1024, 1024}; } r -= CV_OUT;
    if (r < 2 * CV_G) { const int up = r >= CV_G; if (up) r -= CV_G; const int e = r / 256, q = r % 256, kb = q / 16, nb = q % 16, n0 = nb * 32;
        const int drow = e * 1024 + (n0 >> 7) * 256 + (n0 & 127) + (up ? 128 : 0);
        return CvItem{(up ? F.w_eu : F.w_eg) + (size_t)e * 1024 * 512 + (size_t)(64 * kb) * 512 + n0, W1 + (size_t)drow * 1024 + 64 * kb, 512, 1024}; } r -= 2 * CV_G;
    { const int e = r / 256, q = r % 256, kb = q / 32, nb = q % 32;
      return CvItem{F.w_ed + (size_t)e * 512 * 1024 + (size_t)(64 * kb) * 1024 + nb * 32, WdT + (size_t)(e * 1024 + nb * 32) * 512 + 64 * kb, 1024, 512}; }
}
__device__ __forceinline__ void convert_range(const Frame& F, int first, int end, int stride, int base, LAS float* scr) {
    int it = first; if (it >= end) return;
    const int lane = F.lane;
    CvItem c = cv_decode(F, base + it); f32x4 v[8]; cv_load(c, v, lane);
    for (;;) {
        const int itn = it + stride;
        if (itn < end) { const CvItem cn = cv_decode(F, base + itn); f32x4 vn[8]; cv_load(cn, vn, lane); cv_finish(c, v, scr, lane); c = cn;
#pragma unroll
            for (int i = 0; i < 8; ++i) v[i] = vn[i];
            it = itn; }
        else { cv_finish(c, v, scr, lane); break; }
    }
}
__device__ __forceinline__ void p0_prologue(Frame& F) {
    LAS float* scr = (LAS float*)(F.lds + F.wave * 16384);
    const int gw = F.vcu * NWAVES + F.wave, NGW = F.G * NWAVES;
    convert_range(F, gw, N_EARLY, NGW, 0, scr);
    bf16* XN = (bf16*)(F.ws + WS_XN);
    f32x4 gv[4];
#pragma unroll
    for (int j = 0; j < 4; ++j) gv[j] = ((const GAS f32x4*)F.ln1_g)[F.lane + 64 * j];
    for (int m = gw; m < M; m += NGW) {
        const GAS f32x4* xr = (const GAS f32x4*)(F.x + (size_t)m * D) + F.lane;
        f32x4 v[4]; float s = 0.f;
#pragma unroll
        for (int j = 0; j < 4; ++j) { v[j] = xr[64 * j]; s += (v[j].x * v[j].x + v[j].y * v[j].y) + (v[j].z * v[j].z + v[j].w * v[j].w); }
        const float rstd = 1.0f / sqrtf(wave_sum(s) * (1.f / D) + EPS);
        GAS unsigned long long* o8 = (GAS unsigned long long*)(XN + (size_t)m * D) + F.lane;
#pragma unroll
        for (int j = 0; j < 4; ++j) { const f32x4 t = v[j] * rstd * gv[j]; o8[64 * j] = (unsigned long long)pk2(t.x, t.y) | ((unsigned long long)pk2(t.z, t.w) << 32); }
    }
}

typedef float f32x16 __attribute__((ext_vector_type(16)));
typedef short bf16x8v __attribute__((ext_vector_type(8)));
typedef short s16x4 __attribute__((ext_vector_type(4)));
typedef short v4i16_t __attribute__((ext_vector_type(4)));
__device__ __forceinline__ s16x4 vtr(const LAS unsigned char* p) { return __builtin_bit_cast(s16x4, __builtin_amdgcn_ds_read_tr16_b64_v4i16((LAS v4i16_t*)p)); }
__device__ __forceinline__ unsigned cvtpk(float lo, float hi) { typedef float f2 __attribute__((ext_vector_type(2))); typedef __bf16 b2 __attribute__((ext_vector_type(2))); f2 v = {lo, hi}; return __builtin_bit_cast(unsigned, __builtin_convertvector(v, b2)); }
__device__ __forceinline__ void sb_attn_unit_mfma(Frame& F, int unit, bf16* Ydst) {
    const int lane = F.lane, r32 = lane & 31, hi = lane >> 5;
    const int bh = unit >> 8, qb = unit & 255, b = bh >> 3, h = bh & 7, t0 = qb * 32;
    bf16* Qs = (bf16*)(F.ws + WS_QS); const bf16* Kb = (const bf16*)(F.ws + WS_KS) + (size_t)(b * SEQ) * HW + h * 64; const bf16* Vb = (const bf16*)(F.ws + WS_VS) + (size_t)(b * SEQ) * HW + h * 64;
    LAS unsigned char* vl = F.lds + F.wave * 8192;
    bf16x8v qf[4];
    { const bf16* Qg = Qs + (size_t)(b * SEQ + t0 + r32) * HW + h * 64 + hi * 8;
#pragma unroll
      for (int d0 = 0; d0 < 4; ++d0) qf[d0] = *(const bf16x8v*)(Qg + d0 * 16); }
    const int trow = t0 + r32;
    const int ktd = t0 >> 6;
    int kt = ktd;
    bf16x8v kf[8]; v4u vf[8];
#define SB_LOADK(T) do { const bf16* kp_ = Kb + (size_t)((T) * 64 + r32) * HW + hi * 8; _Pragma("unroll") for (int d0 = 0; d0 < 4; ++d0) { kf[d0] = *(const bf16x8v*)(kp_ + d0 * 16); kf[4 + d0] = *(const bf16x8v*)(kp_ + (size_t)32 * HW + d0 * 16); } } while (0)
#define SB_LOADV(T) do { const bf16* vp_ = Vb + (size_t)((T) * 64 + (lane >> 2)) * HW + (lane & 3) * 8; _Pragma("unroll") for (int p = 0; p < 8; ++p) vf[p] = *(const v4u*)(vp_ + (size_t)(16 * (p & 3)) * HW + (p >> 2) * 32); } while (0)
    SB_LOADK(kt); SB_LOADV(kt);
    f32x16 o0, o1;
#pragma unroll
    for (int r = 0; r < 16; ++r) { o0[r] = 0.f; o1[r] = 0.f; }
    float C = 1.0f;
    const LAS unsigned char* vb = vl + ((lane >> 4) & 1) * 32 + (lane & 3) * 8 + (4 * hi + ((lane & 15) >> 2)) * 64;
    constexpr float SC = 0.125f * 1.4426950408889634f, EXITP = 9.3576e-14f;
    for (;;) {
        f32x16 p0, p1;
#pragma unroll
        for (int r = 0; r < 16; ++r) { p0[r] = 0.f; p1[r] = 0.f; }
#pragma unroll
        for (int d0 = 0; d0 < 4; ++d0) { p0 = __builtin_amdgcn_mfma_f32_32x32x16_bf16(kf[d0], qf[d0], p0, 0, 0, 0); p1 = __builtin_amdgcn_mfma_f32_32x32x16_bf16(kf[4 + d0], qf[d0], p1, 0, 0, 0); }
#pragma unroll
        for (int p = 0; p < 8; ++p) *(LAS v4u*)(vl + p * 1024 + lane * 16) = vf[p];
        const int k0 = kt * 64; const bool diag = (kt == ktd);
        { const int ktn = kt > 0 ? kt - 1 : 0; SB_LOADK(ktn); SB_LOADV(ktn); }
        float s0[16], s1[16];
#pragma unroll
        for (int r = 0; r < 16; ++r) { p0[r] = __builtin_amdgcn_rcpf(1.0f + __builtin_amdgcn_exp2f(-p0[r] * SC)); p1[r] = __builtin_amdgcn_rcpf(1.0f + __builtin_amdgcn_exp2f(-p1[r] * SC)); s0[r] = 1.0f - p0[r]; s1[r] = 1.0f - p1[r]; }
        if (diag) {
#pragma unroll
            for (int r = 0; r < 16; ++r) { const int key = k0 + (r & 3) + 8 * (r >> 2) + 4 * hi; if (!(key < trow)) { p0[r] = 0.f; s0[r] = 1.0f; } if (!(key + 32 < trow)) { p1[r] = 0.f; s1[r] = 1.0f; } }
        }
#pragma unroll
        for (int rb = 0; rb < 4; ++rb) { s0[4 * rb + 2] *= s0[4 * rb + 3]; s0[4 * rb + 1] *= s0[4 * rb + 2]; s0[4 * rb] *= s0[4 * rb + 1];
                                         s1[4 * rb + 2] *= s1[4 * rb + 3]; s1[4 * rb + 1] *= s1[4 * rb + 2]; s1[4 * rb] *= s1[4 * rb + 1]; }
        float off0[4], off1[4]; float run = C;
#pragma unroll
        for (int rb = 3; rb >= 0; --rb) { const float me = s1[4 * rb], ot = __shfl_xor(me, 32); off1[rb] = run * (hi == 0 ? ot : 1.0f); run *= me * ot; }
#pragma unroll
        for (int rb = 3; rb >= 0; --rb) { const float me = s0[4 * rb], ot = __shfl_xor(me, 32); off0[rb] = run * (hi == 0 ? ot : 1.0f); run *= me * ot; }
#pragma unroll
        for (int rb = 0; rb < 4; ++rb) {
            p0[4 * rb] *= s0[4 * rb + 1] * off0[rb]; p0[4 * rb + 1] *= s0[4 * rb + 2] * off0[rb]; p0[4 * rb + 2] *= s0[4 * rb + 3] * off0[rb]; p0[4 * rb + 3] *= off0[rb];
            p1[4 * rb] *= s1[4 * rb + 1] * off1[rb]; p1[4 * rb + 1] *= s1[4 * rb + 2] * off1[rb]; p1[4 * rb + 2] *= s1[4 * rb + 3] * off1[rb]; p1[4 * rb + 3] *= off1[rb]; }
        C = run;
        v4u pw[4];
        pw[0] = (v4u){cvtpk(p0[0], p0[1]), cvtpk(p0[2], p0[3]), cvtpk(p0[4], p0[5]), cvtpk(p0[6], p0[7])};
        pw[1] = (v4u){cvtpk(p0[8], p0[9]), cvtpk(p0[10], p0[11]), cvtpk(p0[12], p0[13]), cvtpk(p0[14], p0[15])};
        pw[2] = (v4u){cvtpk(p1[0], p1[1]), cvtpk(p1[2], p1[3]), cvtpk(p1[4], p1[5]), cvtpk(p1[6], p1[7])};
        pw[3] = (v4u){cvtpk(p1[8], p1[9]), cvtpk(p1[10], p1[11]), cvtpk(p1[12], p1[13]), cvtpk(p1[14], p1[15])};
#pragma unroll
        for (int ks = 0; ks < 4; ++ks) {
            const s16x4 l0 = vtr(vb + ks * 1024), h0 = vtr(vb + ks * 1024 + 512), l1 = vtr(vb + 4096 + ks * 1024), h1 = vtr(vb + 4096 + ks * 1024 + 512);
            const bf16x8v b0 = (bf16x8v){l0[0], l0[1], l0[2], l0[3], h0[0], h0[1], h0[2], h0[3]}, b1 = (bf16x8v){l1[0], l1[1], l1[2], l1[3], h1[0], h1[1], h1[2], h1[3]};
            const bf16x8v pa = __builtin_bit_cast(bf16x8v, pw[ks]);
            o0 = __builtin_amdgcn_mfma_f32_32x32x16_bf16(pa, b0, o0, 0, 0, 0); o1 = __builtin_amdgcn_mfma_f32_32x32x16_bf16(pa, b1, o1, 0, 0, 0);
        }
        if (kt == 0) break;
        if (__all(C < EXITP)) break;
        --kt;
    }
#undef SB_LOADK
#undef SB_LOADV
    { bf16* yp = Ydst + (size_t)(b * SEQ + t0) * HW + h * 64 + r32;
#pragma unroll
      for (int r = 0; r < 16; ++r) { const int q = (r & 3) + 8 * (r >> 2) + 4 * hi; yp[(size_t)q * HW] = (bf16)f2bf(o0[r]); yp[(size_t)q * HW + 32] = (bf16)f2bf(o1[r]); } }
    LDS_WAIT();
}

__device__ __forceinline__ void hg_scan(Frame& F, int blk) {
    if (F.tid >= 256) return;
    const int gid = blk * 256 + F.tid;
    const int bh = gid >> 12, vk = gid & 4095, k = vk & 63;
    const bf16* S = (const bf16*)(F.ws + WS_XN) + (size_t)bh * 128 * 4096 + vk; const float* dec = (const float*)(F.ws + WS_SMALL + SM_DEC) + (size_t)(bh >> 3) * 128 * 512 + (bh & 7) * 64 + k;
    bf16* O = (bf16*)(F.ws + WS_SIN) + (size_t)bh * 128 * 4096 + vk;
    float run = 0.f;
    for (int c0 = 0; c0 < 128; c0 += 16) {
        float loc[16], d[16];
#pragma unroll
        for (int i = 0; i < 16; ++i) { loc[i] = bf2f(S[(size_t)(c0 + i) * 4096]); d[i] = dec[(c0 + i) * 512]; }
#pragma unroll
        for (int i = 0; i < 16; ++i) { O[(size_t)(c0 + i) * 4096] = (bf16)f2bf(run); run = run * d[i] + loc[i]; }
    }
}

template <int CTRL> __device__ __forceinline__ float dppf(float v) { return __builtin_bit_cast(float, __builtin_amdgcn_update_dpp(0, __builtin_bit_cast(int, v), CTRL, 0xF, 0xF, true)); }
__device__ __forceinline__ bf16x8v trfrag(const LAS unsigned char* p) { const s16x4 l = vtr(p), h = vtr(p + 512); return (bf16x8v){l[0], l[1], l[2], l[3], h[0], h[1], h[2], h[3]}; }
__device__ __forceinline__ void zero16(f32x16& a) {
#pragma unroll
    for (int r = 0; r < 16; ++r) a[r] = 0.f;
}
__device__ __forceinline__ void hg_local_mfma(Frame& F, int unit) {
    int lane_ = F.lane; asm volatile("" : "+v"(lane_));
    const int bh = unit >> 7, c = unit & 127, b = bh >> 3, h = bh & 7; const int lane = lane_, r32 = lane & 31, hi = lane >> 5;
    const size_t row0 = (size_t)b * SEQ + (size_t)c * 64;
    LAS unsigned char* kdI = F.lds + F.wave * 16384; LAS unsigned char* vI = kdI + 8192;
    { const bf16* vp_ = (const bf16*)(F.ws + WS_VH) + (row0 + (lane >> 2)) * HW + h * 64 + (lane & 3) * 8;
#pragma unroll
      for (int p = 0; p < 8; ++p) { const v4u t = *(const v4u*)(vp_ + (size_t)(16 * (p & 3)) * HW + (p >> 2) * 32); *(LAS v4u*)(vI + p * 1024 + lane * 16) = t; } }
    {
        const int k0 = (lane & 7) * 8, sr = lane >> 3;
        const bf16* kp = (const bf16*)(F.ws + WS_KH) + row0 * HW + h * 64 + k0;
#pragma unroll
        for (int i = 0; i < 8; ++i) { const int s2 = sr + 8 * i; const v4u kk = *(const v4u*)(kp + (size_t)s2 * HW);
            *(LAS v4u*)(kdI + ((k0 >> 5) * 4 + (s2 >> 4)) * 1024 + (s2 & 15) * 64 + (k0 & 31) * 2) = kk; }
    }
    const float* elm = (const float*)(F.ws + WS_SMALL + SM_ELM) + (size_t)(b * 128 + c) * 512 + h * 64 + r32;
    const float e0 = elm[0], e1 = elm[32];
    LDS_WAIT();
    const int vb = ((lane >> 4) & 1) * 32 + (lane & 3) * 8 + (4 * hi + ((lane & 15) >> 2)) * 64;
    f32x16 a00, a01, a10, a11; zero16(a00); zero16(a01); zero16(a10); zero16(a11);
#pragma unroll
    for (int ks = 0; ks < 4; ++ks) {
        const bf16x8v k0 = trfrag(kdI + vb + ks * 1024), k1 = trfrag(kdI + vb + 4096 + ks * 1024), v0 = trfrag(vI + vb + ks * 1024), v1 = trfrag(vI + vb + 4096 + ks * 1024);
        a00 = __builtin_amdgcn_mfma_f32_32x32x16_bf16(v0, k0, a00, 0, 0, 0); a01 = __builtin_amdgcn_mfma_f32_32x32x16_bf16(v0, k1, a01, 0, 0, 0);
        a10 = __builtin_amdgcn_mfma_f32_32x32x16_bf16(v1, k0, a10, 0, 0, 0); a11 = __builtin_amdgcn_mfma_f32_32x32x16_bf16(v1, k1, a11, 0, 0, 0);
    }
    bf16* Sl = (bf16*)(F.ws + WS_XN) + (size_t)unit * 4096 + r32;
#pragma unroll
    for (int r = 0; r < 16; ++r) { const int v = (r & 3) + 8 * (r >> 2) + 4 * hi;
        Sl[v * 64] = (bf16)f2bf(a00[r] * e0); Sl[v * 64 + 32] = (bf16)f2bf(a01[r] * e1); Sl[(v + 32) * 64] = (bf16)f2bf(a10[r] * e0); Sl[(v + 32) * 64 + 32] = (bf16)f2bf(a11[r] * e1); }
    LDS_WAIT();
}
__device__ __forceinline__ void hg_out_mfma(Frame& F, int unit) {
    int lane_ = F.lane; asm volatile("" : "+v"(lane_));
    const int bh = unit >> 7, c = unit & 127, b = bh >> 3, h = bh & 7; const int lane = lane_, r32 = lane & 31, hi = lane >> 5;
    const size_t row0 = (size_t)b * SEQ + (size_t)c * 64;
    LAS unsigned char* img = F.lds + F.wave * 8192;
    { const bf16* vp_ = (const bf16*)(F.ws + WS_VH) + (row0 + (lane >> 2)) * HW + h * 64 + (lane & 3) * 8;
#pragma unroll
      for (int p = 0; p < 8; ++p) { const v4u t = *(const v4u*)(vp_ + (size_t)(16 * (p & 3)) * HW + (p >> 2) * 32); *(LAS v4u*)(img + p * 1024 + lane * 16) = t; } }
    const bf16* SinT = (const bf16*)(F.ws + WS_SIN) + (size_t)unit * 4096 + (size_t)r32 * 64 + 8 * hi;
    const bf16* eap = (const bf16*)(F.ws + WS_LOGF) + row0 * HW + h * 64 + 8 * hi;
    const bf16* qp = (const bf16*)(F.ws + WS_QH) + row0 * HW + h * 64 + 8 * hi;
    const bf16* kp = (const bf16*)(F.ws + WS_KH) + row0 * HW + h * 64 + 8 * hi;
    const float* emp = (const float*)(F.ws + WS_SMALL + SM_EMID) + (size_t)(b * 128 + c) * 512 + h * 64 + 8 * hi;
    bf16x8v Af[2][4], Bf[2][4];
    f32x16 o00, o01, o10, o11; zero16(o00); zero16(o01); zero16(o10); zero16(o11);
#pragma unroll
    for (int ks = 0; ks < 4; ++ks) {
        const f32x4 e0_ = *(const f32x4*)(emp + 16 * ks), e1_ = *(const f32x4*)(emp + 16 * ks + 4);
        const float em[8] = {e0_.x, e0_.y, e0_.z, e0_.w, e1_.x, e1_.y, e1_.z, e1_.w};
        const bf16x8v sf0 = *(const bf16x8v*)(SinT + 16 * ks), sf1 = *(const bf16x8v*)(SinT + 32 * 64 + 16 * ks);
        bf16x8v As[2];
#pragma unroll
        for (int rb = 0; rb < 2; ++rb) { const size_t ro = (size_t)(32 * rb + r32) * HW + 16 * ks;
            const v4u qq = *(const v4u*)(qp + ro), kk = *(const v4u*)(kp + ro), ee = *(const v4u*)(eap + ro);
            const float a[8] = {blo(qq.x) * blo(ee.x), bhi(qq.x) * bhi(ee.x), blo(qq.y) * blo(ee.y), bhi(qq.y) * bhi(ee.y), blo(qq.z) * blo(ee.z), bhi(qq.z) * bhi(ee.z), blo(qq.w) * blo(ee.w), bhi(qq.w) * bhi(ee.w)};
            const v4u wa = (v4u){cvtpk(a[0], a[1]), cvtpk(a[2], a[3]), cvtpk(a[4], a[5]), cvtpk(a[6], a[7])};
            const v4u wb = kk;
            const v4u ws_ = (v4u){cvtpk(a[0] * em[0], a[1] * em[1]), cvtpk(a[2] * em[2], a[3] * em[3]), cvtpk(a[4] * em[4], a[5] * em[5]), cvtpk(a[6] * em[6], a[7] * em[7])};
            Af[rb][ks] = __builtin_bit_cast(bf16x8v, wa); Bf[rb][ks] = __builtin_bit_cast(bf16x8v, wb); As[rb] = __builtin_bit_cast(bf16x8v, ws_); }
        o00 = __builtin_amdgcn_mfma_f32_32x32x16_bf16(As[0], sf0, o00, 0, 0, 0); o01 = __builtin_amdgcn_mfma_f32_32x32x16_bf16(As[0], sf1, o01, 0, 0, 0);
        o10 = __builtin_amdgcn_mfma_f32_32x32x16_bf16(As[1], sf0, o10, 0, 0, 0); o11 = __builtin_amdgcn_mfma_f32_32x32x16_bf16(As[1], sf1, o11, 0, 0, 0);

    }
    f32x16 s00, s01, s11; zero16(s00); zero16(s01); zero16(s11);
#pragma unroll
    for (int ks = 0; ks < 4; ++ks) { s00 = __builtin_amdgcn_mfma_f32_32x32x16_bf16(Bf[0][ks], Af[0][ks], s00, 0, 0, 0); s01 = __builtin_amdgcn_mfma_f32_32x32x16_bf16(Bf[0][ks], Af[1][ks], s01, 0, 0, 0);
        s11 = __builtin_amdgcn_mfma_f32_32x32x16_bf16(Bf[1][ks], Af[1][ks], s11, 0, 0, 0); }
#pragma unroll
    for (int r = 0; r < 16; ++r) { const int sl = (r & 3) + 8 * (r >> 2) + 4 * hi; if (sl > r32) { s00[r] = 0.f; s11[r] = 0.f; } }
    v4u p00[2], p01[2], p11[2];
#pragma unroll
    for (int k2 = 0; k2 < 2; ++k2) {
        p00[k2] = (v4u){cvtpk(s00[8 * k2], s00[8 * k2 + 1]), cvtpk(s00[8 * k2 + 2], s00[8 * k2 + 3]), cvtpk(s00[8 * k2 + 4], s00[8 * k2 + 5]), cvtpk(s00[8 * k2 + 6], s00[8 * k2 + 7])};
        p01[k2] = (v4u){cvtpk(s01[8 * k2], s01[8 * k2 + 1]), cvtpk(s01[8 * k2 + 2], s01[8 * k2 + 3]), cvtpk(s01[8 * k2 + 4], s01[8 * k2 + 5]), cvtpk(s01[8 * k2 + 6], s01[8 * k2 + 7])};
        p11[k2] = (v4u){cvtpk(s11[8 * k2], s11[8 * k2 + 1]), cvtpk(s11[8 * k2 + 2], s11[8 * k2 + 3]), cvtpk(s11[8 * k2 + 4], s11[8 * k2 + 5]), cvtpk(s11[8 * k2 + 6], s11[8 * k2 + 7])};
    }
    LDS_WAIT();
    const int vb = ((lane >> 4) & 1) * 32 + (lane & 3) * 8 + (4 * hi + ((lane & 15) >> 2)) * 64;
#pragma unroll
    for (int k2 = 0; k2 < 2; ++k2) {
        const bf16x8v v0a = trfrag(img + vb + k2 * 1024), v1a = trfrag(img + vb + 4096 + k2 * 1024);
        const bf16x8v v0b = trfrag(img + vb + (2 + k2) * 1024), v1b = trfrag(img + vb + 4096 + (2 + k2) * 1024);
        const bf16x8v a00 = __builtin_bit_cast(bf16x8v, p00[k2]), a01 = __builtin_bit_cast(bf16x8v, p01[k2]), a11 = __builtin_bit_cast(bf16x8v, p11[k2]);
        o00 = __builtin_amdgcn_mfma_f32_32x32x16_bf16(a00, v0a, o00, 0, 0, 0); o01 = __builtin_amdgcn_mfma_f32_32x32x16_bf16(a00, v1a, o01, 0, 0, 0);
        o10 = __builtin_amdgcn_mfma_f32_32x32x16_bf16(a01, v0a, o10, 0, 0, 0); o11 = __builtin_amdgcn_mfma_f32_32x32x16_bf16(a01, v1a, o11, 0, 0, 0);
        o10 = __builtin_amdgcn_mfma_f32_32x32x16_bf16(a11, v0b, o10, 0, 0, 0); o11 = __builtin_amdgcn_mfma_f32_32x32x16_bf16(a11, v1b, o11, 0, 0, 0);
    }
    LDS_WAIT();
    { LAS bf16* ot = (LAS bf16*)img + r32;
#pragma unroll
      for (int r = 0; r < 16; ++r) { const int t = (r & 3) + 8 * (r >> 2) + 4 * hi;
          ot[t * 64] = (bf16)f2bf(o00[r]); ot[t * 64 + 32] = (bf16)f2bf(o01[r]); ot[(t + 32) * 64] = (bf16)f2bf(o10[r]); ot[(t + 32) * 64 + 32] = (bf16)f2bf(o11[r]); } }
    LDS_WAIT();
    { int lane2 = lane; asm volatile("" : "+v"(lane2));
      const int v0e = (lane2 & 7) * 8, tre = lane2 >> 3; const bf16* ghp = (const bf16*)(F.ws + WS_GH) + row0 * HW + h * 64 + v0e;
      const f32x4 g0 = *(const f32x4*)(F.hg_norm_g + h * 64 + v0e), g1 = *(const f32x4*)(F.hg_norm_g + h * 64 + v0e + 4);
      bf16* yp = (bf16*)(F.ws + WS_KS) + row0 * HW + h * 64 + v0e;
#pragma unroll
      for (int i = 0; i < 8; ++i) { const int t = tre + 8 * i;
          const v4u ov = *(const LAS v4u*)(img + t * 128 + v0e * 2); const v4u gg = *(const v4u*)(ghp + (size_t)t * HW);
          const float o[8] = {blo(ov.x), bhi(ov.x), blo(ov.y), bhi(ov.y), blo(ov.z), bhi(ov.z), blo(ov.w), bhi(ov.w)};
          float q = (o[0] * o[0] + o[1] * o[1]) + (o[2] * o[2] + o[3] * o[3]) + (o[4] * o[4] + o[5] * o[5]) + (o[6] * o[6] + o[7] * o[7]);
          q += dppf<0xB1>(q); q += dppf<0x4E>(q); q += dppf<0x141>(q);
          const float rs = 1.0f / sqrtf(q * (1.f / 64.f) + EPS);
          v4u w; w.x = cvtpk(o[0] * rs * g0.x * blo(gg.x), o[1] * rs * g0.y * bhi(gg.x)); w.y = cvtpk(o[2] * rs * g0.z * blo(gg.y), o[3] * rs * g0.w * bhi(gg.y));
          w.z = cvtpk(o[4] * rs * g1.x * blo(gg.z), o[5] * rs * g1.y * bhi(gg.z)); w.w = cvtpk(o[6] * rs * g1.z * blo(gg.w), o[7] * rs * g1.w * bhi(gg.w));
          *(v4u*)(yp + (size_t)t * HW) = w; } }
    LDS_WAIT();
}

__device__ __forceinline__ void router_phase(Frame& F) {
    LAS float* xs = (LAS float*)(F.lds + F.wave * 11136);
    LAS float* We = xs + 64 * 33;
    LAS float* Wg = We + 32 * 16;
    LAS float* Gc = Wg + 32 * 4;
    LAS float* part = (LAS float*)(F.lds + 8 * 11136);
    LAS int* lh = (LAS int*)(F.lds + 8 * 11136 + 8 * 21 * 64 * 4);
    LAS float* lrs = (LAS float*)(lh + 16);
    const int lane = F.lane;
    int* tok_e = (int*)(F.ws + WS_SMALL + SM_TOKE); float* tok_w = (float*)(F.ws + WS_SMALL + SM_TOKW); float* tok_r = (float*)(F.ws + WS_SMALL + SM_RSTD);
    for (int blk = F.vcu; blk < M / 64; blk += F.G) {
        if (F.tid < 16) lh[F.tid] = 0;
        float ss = 0.f, ag[4] = {0.f, 0.f, 0.f, 0.f}, ae[16];
#pragma unroll
        for (int j = 0; j < 16; ++j) ae[j] = 0.f;
        const bf16* xb = (const bf16*)(F.ws + WS_X1) + (size_t)(blk * 64) * D + F.wave * 128;
        v4u v[4]; f32x4 we0, we1, wg, gg;
#define RT_LOAD(CH) do { const int c0_ = F.wave * 128 + (CH) * 32; \
            _Pragma("unroll") for (int j = 0; j < 4; ++j) v[j] = *(const GAS v4u*)(xb + (size_t)((lane >> 2) + 16 * j) * D + (CH) * 32 + (lane & 3) * 8); \
            we0 = *(const GAS f32x4*)(F.w_re + (size_t)c0_ * 16 + lane * 4); we1 = *(const GAS f32x4*)(F.w_re + (size_t)c0_ * 16 + 256 + lane * 4); \
            wg = *(const GAS f32x4*)(F.w_rg + (size_t)c0_ * 4 + (lane & 31) * 4); gg = *(const GAS f32x4*)(F.ln2_g + c0_ + (lane & 7) * 4); } while (0)
        RT_LOAD(0);
        for (int ch = 0; ch < 4; ++ch) {
#pragma unroll
            for (int j = 0; j < 4; ++j) { LAS float* d = xs + ((lane >> 2) + 16 * j) * 33 + (lane & 3) * 8; d[0] = blo(v[j].x); d[1] = bhi(v[j].x); d[2] = blo(v[j].y); d[3] = bhi(v[j].y); d[4] = blo(v[j].z); d[5] = bhi(v[j].z); d[6] = blo(v[j].w); d[7] = bhi(v[j].w); }
            *(LAS f32x4*)(We + lane * 4) = we0; *(LAS f32x4*)(We + 256 + lane * 4) = we1;
            if (lane < 32) *(LAS f32x4*)(Wg + lane * 4) = wg;
            if (lane < 8) *(LAS f32x4*)(Gc + lane * 4) = gg;
            LDS_WAIT();
            if (ch < 3) RT_LOAD(ch + 1);
#pragma unroll 4
            for (int cc = 0; cc < 32; ++cc) {
                const float xv = xs[lane * 33 + cc]; const float xg = xv * Gc[cc];
                ss += xv * xv;
                const f32x4 g4 = *(const LAS f32x4*)(Wg + cc * 4);
                ag[0] += xg * g4.x; ag[1] += xg * g4.y; ag[2] += xg * g4.z; ag[3] += xg * g4.w;
#pragma unroll
                for (int r = 0; r < 4; ++r) { const f32x4 e4 = *(const LAS f32x4*)(We + cc * 16 + 4 * r);
                    ae[4 * r] += xg * e4.x; ae[4 * r + 1] += xg * e4.y; ae[4 * r + 2] += xg * e4.z; ae[4 * r + 3] += xg * e4.w; }
            }
            LDS_WAIT();
        }
#undef RT_LOAD
        part[(F.wave * 21 + 0) * 64 + lane] = ss;
#pragma unroll
        for (int j = 0; j < 4; ++j) part[(F.wave * 21 + 1 + j) * 64 + lane] = ag[j];
#pragma unroll
        for (int j = 0; j < 16; ++j) part[(F.wave * 21 + 5 + j) * 64 + lane] = ae[j];
        __syncthreads();
        if (F.wave == 0) {
            const int tok = blk * 64 + lane;
            ss = 0.f;
#pragma unroll
            for (int j = 0; j < 4; ++j) ag[j] = 0.f;
#pragma unroll
            for (int j = 0; j < 16; ++j) ae[j] = 0.f;
#pragma unroll
            for (int w = 0; w < 8; ++w) { ss += part[(w * 21) * 64 + lane];
#pragma unroll
                for (int j = 0; j < 4; ++j) ag[j] += part[(w * 21 + 1 + j) * 64 + lane];
#pragma unroll
                for (int j = 0; j < 16; ++j) ae[j] += part[(w * 21 + 5 + j) * 64 + lane]; }
            const float rstd = 1.0f / sqrtf(ss * (1.f / D) + EPS);
            float gl[4];
#pragma unroll
            for (int j = 0; j < 4; ++j) gl[j] = ag[j] * rstd + F.b_rg[j];
            int gi = 0; float gm = gl[0];
#pragma unroll
            for (int j = 1; j < 4; ++j) if (gl[j] > gm) { gm = gl[j]; gi = j; }
            float den = 0.f;
#pragma unroll
            for (int j = 0; j < 4; ++j) den += __expf(gl[j] - gm);
            const float wgrp = 1.0f / den;
            float el[4];
#pragma unroll
            for (int q = 0; q < 4; ++q) { float v = ae[q]; float bb = F.b_re[q];
#pragma unroll
                for (int g2 = 1; g2 < 4; ++g2) { v = (gi == g2) ? ae[g2 * 4 + q] : v; bb = (gi == g2) ? F.b_re[g2 * 4 + q] : bb; }
                el[q] = v * rstd + bb; }
            int i0 = 0; float v0 = el[0];
#pragma unroll
            for (int q = 1; q < 4; ++q) if (el[q] > v0) { v0 = el[q]; i0 = q; }
            int i1 = -1; float v1 = 0.f;
#pragma unroll
            for (int q = 0; q < 4; ++q) if (q != i0 && (i1 < 0 || el[q] > v1)) { v1 = el[q]; i1 = q; }
            const float ex = __expf(v1 - v0); const float p0 = 1.0f / (1.0f + ex), p1 = ex / (1.0f + ex);
            const int e0 = gi * 4 + i0, e1 = gi * 4 + i1;
            *(v2u*)(tok_e + tok * 2) = (v2u){(unsigned)e0, (unsigned)e1};
            typedef float f32x2 __attribute__((ext_vector_type(2)));
            *(f32x2*)(tok_w + tok * 2) = (f32x2){p0 * wgrp, p1 * wgrp}; tok_r[tok] = rstd; lrs[lane] = rstd;
            __hip_atomic_fetch_add(&lh[e0], 1, __ATOMIC_RELAXED, __HIP_MEMORY_SCOPE_WORKGROUP); __hip_atomic_fetch_add(&lh[e1], 1, __ATOMIC_RELAXED, __HIP_MEMORY_SCOPE_WORKGROUP);
        }
        __syncthreads();
        if (F.tid < 16) ((int*)(F.ws + WS_SMALL + SM_HIST))[blk * 16 + F.tid] = lh[F.tid];
        {
            bf16* TN = (bf16*)(F.ws + WS_TS); f32x4 gq[4];
#pragma unroll
            for (int j = 0; j < 4; ++j) gq[j] = ((const GAS f32x4*)F.ln2_g)[lane + 64 * j];
            for (int i0 = 0; i0 < 8; i0 += 4) {
                v2u xv[4][4];
#pragma unroll
                for (int u = 0; u < 4; ++u) { const GAS v2u* xr = (const GAS v2u*)((const bf16*)(F.ws + WS_X1) + (size_t)(blk * 64 + F.wave * 8 + i0 + u) * D) + lane;
#pragma unroll
                    for (int j = 0; j < 4; ++j) xv[u][j] = xr[64 * j]; }
#pragma unroll
                for (int u = 0; u < 4; ++u) { const int tl = F.wave * 8 + i0 + u; const float rs = lrs[tl];
                    GAS unsigned long long* o0 = (GAS unsigned long long*)(TN + (size_t)(blk * 64 + tl) * D) + lane;
#pragma unroll
                    for (int j = 0; j < 4; ++j) { const f32x4 t = (f32x4){blo(xv[u][j].x), bhi(xv[u][j].x), blo(xv[u][j].y), bhi(xv[u][j].y)} * rs * gq[j]; o0[64 * j] = (unsigned long long)pk2(t.x, t.y) | ((unsigned long long)pk2(t.z, t.w) << 32); } }
            }
        }
        __syncthreads();
    }
}

__device__ __forceinline__ void sort_gather_phase(Frame& F) {
    LAS int* L = (LAS int*)(F.lds);
    const int* hist = (const int*)(F.ws + WS_SMALL + SM_HIST);
    int* rowtok = (int*)(F.ws + WS_SMALL + SM_ROWTOK); float* roww = (float*)(F.ws + WS_SMALL + SM_ROWW);
    const int* tok_e = (const int*)(F.ws + WS_SMALL + SM_TOKE); const float* tok_w = (const float*)(F.ws + WS_SMALL + SM_TOKW); const float* tok_r = (const float*)(F.ws + WS_SMALL + SM_RSTD);
    const int lane = F.lane;
    for (int blk = F.vcu; blk < M / 64; blk += F.G) {
        if (F.tid < 32) L[F.tid] = 0;
        __syncthreads();
        { const int e = F.tid & 15, bg = F.tid >> 4; int tot = 0, base = 0;
#pragma unroll
          for (int i = 0; i < 8; ++i) { const int b2 = bg + 32 * i; const int hv = hist[b2 * 16 + e]; tot += hv; base += (b2 < blk) ? hv : 0; }
          __hip_atomic_fetch_add(&L[e], tot, __ATOMIC_RELAXED, __HIP_MEMORY_SCOPE_WORKGROUP); __hip_atomic_fetch_add(&L[16 + e], base, __ATOMIC_RELAXED, __HIP_MEMORY_SCOPE_WORKGROUP); }
        __syncthreads();
        if (F.tid == 0) { int p = 0; for (int e = 0; e < 16; ++e) { L[32 + e] = p; L[64 + e] = p * 256; p += (L[e] + 255) >> 8; } L[48] = p;
            if (blk == 0) { int* meta = (int*)(F.ws + WS_SMALL + SM_META); for (int e = 0; e <= 16; ++e) meta[e] = L[32 + e]; } }
        __syncthreads();
        if (F.wave == 0) {
            int run[16];
#pragma unroll
            for (int e = 0; e < 16; ++e) run[e] = 0;
            for (int r = 0; r < 2; ++r) {
                const int i = r * 64 + lane, tok = blk * 64 + (i >> 1), slot = i & 1; const int e = tok_e[tok * 2 + slot]; int pos = 0;
#pragma unroll
                for (int ex = 0; ex < 16; ++ex) { const unsigned long long mk = __ballot(e == ex); const int below = __popcll(mk & ((1ull << lane) - 1ull));
                    if (e == ex) pos = L[64 + ex] + L[16 + ex] + run[ex] + below; run[ex] += __popcll(mk); }
                L[128 + i] = pos; rowtok[pos] = tok * 2 + slot; roww[pos] = tok_w[tok * 2 + slot];
            }
        }
        __syncthreads();
        if (blk < 16) {
            const int first = L[64 + blk] + L[blk], end = L[64 + blk] + (((L[blk] + 255) >> 8) << 8);
            for (int r = first + F.tid; r < end; r += NWAVES * 64) { rowtok[r] = -1; roww[r] = 0.f; }
        }
        __syncthreads();
    }
}

__device__ __forceinline__ void final_phase(Frame& F) {
    const int gw = F.vcu * NWAVES + F.wave, NGW = F.G * NWAVES; const int lane = F.lane;
    const bf16* Y0 = (const bf16*)(F.ws + WS_XN); const bf16* Y1 = (const bf16*)(F.ws + WS_Y1);
    f32x4 gv[4];
#pragma unroll
    for (int j = 0; j < 4; ++j) gv[j] = ((const GAS f32x4*)F.final_g)[lane + 64 * j];
    for (int m0 = gw; m0 < M; m0 += 2 * NGW) {
        f32x4 v[2][4]; float s[2];
#pragma unroll
        for (int u = 0; u < 2; ++u) { const int m = m0 + u * NGW;
            const GAS v2u* xr = (const GAS v2u*)((const bf16*)(F.ws + WS_X1) + (size_t)m * D) + lane;
            const GAS v2u* y0 = (const GAS v2u*)(Y0 + (size_t)m * D) + lane; const GAS v2u* y1 = (const GAS v2u*)(Y1 + (size_t)m * D) + lane;
            s[u] = 0.f;
#pragma unroll
            for (int j = 0; j < 4; ++j) { const v2u a = y0[64 * j], b2 = y1[64 * j], xw = xr[64 * j]; f32x4 t = (f32x4){blo(xw.x), bhi(xw.x), blo(xw.y), bhi(xw.y)};
                t.x += blo(a.x) + blo(b2.x); t.y += bhi(a.x) + bhi(b2.x); t.z += blo(a.y) + blo(b2.y); t.w += bhi(a.y) + bhi(b2.y);
                v[u][j] = t; s[u] += (t.x * t.x + t.y * t.y) + (t.z * t.z + t.w * t.w); } }
#pragma unroll
        for (int u = 0; u < 2; ++u) { const int m = m0 + u * NGW; GAS f32x4* xr = (GAS f32x4*)(F.out + (size_t)m * D) + lane;
            const float rstd = 1.0f / sqrtf(wave_sum(s[u]) * (1.f / D) + EPS);
#pragma unroll
            for (int j = 0; j < 4; ++j) xr[64 * j] = v[u][j] * rstd * gv[j]; }
    }
}

struct Args { const float* in[17]; float* out; unsigned char* ws; int ph_lo, ph_hi, li, pad; };
__global__ void __launch_bounds__(NWAVES * 64, 2) hybrid_fwd(Args args) {
    extern __shared__ __attribute__((aligned(16))) unsigned char lds[];
    Frame F;
    F.lds = (LAS unsigned char*)lds;
    F.MISC = (volatile LAS unsigned*)(F.lds + MISC_OFF);
    F.tid = threadIdx.x; F.lane = F.tid & 63; F.wave = __builtin_amdgcn_readfirstlane(F.tid >> 6);
    F.G = gridDim.x; { const int bx = blockIdx.x; F.vcu = (F.G % 8 == 0) ? (bx % 8) * (F.G / 8) + bx / 8 : bx; }
    unsigned char* ws = args.ws; F.ws = ws;
    F.ctl = (gu32*)(ws + WS_CTL);
    for (int u = F.tid; u < (LDS_BYTES - LDSCTL_OFF) / 4; u += NWAVES * 64) ((LAS unsigned*)(F.lds + LDSCTL_OFF))[u] = 0u;
    __syncthreads();
    F.PT = (volatile LAS unsigned long long*)(F.lds + LDSCTL_OFF + 512);
#pragma unroll
    for (int k = 0; k < 17; ++k) if (F.tid == k) F.PT[k] = (unsigned long long)args.in[k];
    __syncthreads();
    F.out = args.out;
    XcdBarrier bar; bar.bar = g_grid_barrier; bar.x = 0; bar.st = nullptr;
    if (N_LAUNCHES == 1) bar = xcd_barrier_post(g_grid_barrier, F.MISC + 8);
#if defined(PROBE_A0)
#define TS_MARK(i) do { if (threadIdx.x == 0) ((volatile LAS unsigned long long*)(F.lds + LDSCTL_OFF + 1024))[(i)] = __builtin_amdgcn_s_memrealtime(); } while (0)
#else
#define TS_MARK(i) do {} while (0)
#endif
    int nbar = 0;
    TS_MARK(0);
#define GRID_BAR() do { if (N_LAUNCHES == 1) { TS_MARK(1 + 2 * nbar); xcd_barrier(bar); TS_MARK(2 + 2 * nbar); ++nbar; } } while (0)
    const int lo = args.ph_lo, hi = args.ph_hi;
#ifndef PH_MASK
#define PH_MASK 0xFFF
#endif
#define IN(k) ((((PH_MASK) >> (k)) & 1) && lo <= (k) && (k) < hi)
#define BOTH(k) (IN(k) && IN((k) + 1))
#ifndef REP_MASK
#define REP_MASK 0
#endif
#ifndef REP_N
#define REP_N 3
#endif
#define REPF(k) for (int rep_ = 0; rep_ < 1 + ((((REP_MASK) >> (k)) & 1) ? (REP_N) : 0); ++rep_)
#define OPAQUE() do { int t_ = threadIdx.x; asm volatile("" : "+v"(t_)); F.tid = t_; F.lane = t_ & 63; } while (0)
    const int gw = F.vcu * NWAVES + F.wave, NGW = F.G * NWAVES;

    if (IN(0)) { OPAQUE(); } if (IN(0)) REPF(0) { F.x = fin(F, 0); F.ln1_g = fin(F, 1); F.w_in = fin(F, 2); F.w_bsb = fin(F, 3); F.w_bhg = fin(F, 4); F.w_out = fin(F, 7); F.w_eg = fin(F, 13); F.w_eu = fin(F, 14); F.w_ed = fin(F, 15); p0_prologue(F); if (BOTH(0)) GRID_BAR(); }

    if (IN(1)) REPF(1) {
        F.lbl = fin(F, 6); F.w_eg = fin(F, 13); F.w_eu = fin(F, 14); F.w_ed = fin(F, 15); F.w_in = fin(F, 2); F.w_bsb = fin(F, 3); F.w_bhg = fin(F, 4); F.w_out = fin(F, 7);
        pg8::Gemm g{(const bf16*)(ws + WS_XN), (const bf16*)(ws + WS_WIN), M, IN_COLS, D}; pg8::StaticOrder S; S.init(M, IN_COLS, F.G, (int)blockIdx.x);
        pg8::EpiProj E{(bf16*)(ws + WS_QS), (bf16*)(ws + WS_KS), (bf16*)(ws + WS_VS), (bf16*)(ws + WS_QH), (bf16*)(ws + WS_KH), (bf16*)(ws + WS_VH), (bf16*)(ws + WS_GH),
                       (bf16*)F.out, (bf16*)F.out + (size_t)M * D, (float*)(ws + WS_LOGF), (float*)(ws + WS_SMALL + SM_EMID), (float*)(ws + WS_SMALL + SM_ELM), (float*)(ws + WS_SMALL + SM_DEC), F.lbl};
        {
            const int nfull = S.nwg % F.G, c = (int)blockIdx.x; const int nshort = nfull ? F.G - nfull : F.G, idx = nfull ? c - nfull : c;
            if (idx >= 0) { OPAQUE(); LAS float* scr = (LAS float*)(F.lds + F.wave * 16384);
                convert_range(F, idx * NWAVES + F.wave, N_LATE, nshort * NWAVES, N_EARLY, scr); }
            asm volatile("s_waitcnt vmcnt(0) lgkmcnt(0)" ::: "memory"); __syncthreads();
        }
        pg8::gemm_phase<pg8::EpiProj, pg8::StaticOrder, PG8_ALIGN, PG8_SP2>(F.lds, g, S, E);
        if (BOTH(1)) GRID_BAR();
    }

    if (IN(2)) { OPAQUE(); } if (IN(2)) REPF(2) {
        for (int u = gw; u < 2048; u += NGW) hg_local_mfma(F, u);
        if (BOTH(2)) GRID_BAR();
    }

    if (IN(3)) { OPAQUE(); } if (IN(3)) {
        LAS int* aq = (LAS int*)(F.lds + LDSCTL_OFF + 256);
        if (F.tid == 0) aq[0] = 0;
        __syncthreads();
        for (int blk = F.vcu; blk < 256; blk += F.G) hg_scan(F, blk);
        for (;;) { int u = 0; if (F.lane == 0) u = __hip_atomic_fetch_add(aq, 1, __ATOMIC_RELAXED, __HIP_MEMORY_SCOPE_WORKGROUP);
            u = __builtin_amdgcn_readfirstlane(u); const int unit = F.vcu + u * F.G; if (unit >= 4096) break;
            sb_attn_unit_mfma(F, unit, (bf16*)(ws + WS_QS)); }
        if (BOTH(3)) GRID_BAR(); }

    if (IN(4)) { OPAQUE(); } if (IN(4)) REPF(4) { F.hg_norm_g = fin(F, 5); for (int u = gw; u < 2048; u += NGW) hg_out_mfma(F, u); if (BOTH(4)) GRID_BAR(); }

    if (IN(5)) REPF(5) {
        pg8::Gemm g{(const bf16*)(ws + WS_QS), (const bf16*)(ws + WS_WBR), 2 * M, 2048, HW}; pg8::BranchOrder S; S.S.init(M, D, F.G, (int)blockIdx.x);
        pg8::EpiBranch E{(const bf16*)F.out, (const bf16*)F.out + (size_t)M * D, (bf16*)(ws + WS_XN)};
        for (int r = 0; r * F.G < 256; ++r) { S.S.c = (int)blockIdx.x + r * F.G; pg8::gemm_phase<pg8::EpiBranch, pg8::BranchOrder, false, PG8_SP2>(F.lds, g, S, E); }
        if (BOTH(5)) GRID_BAR();
    }

    if (IN(6)) REPF(6) {
        pg8::Gemm g{(const bf16*)(ws + WS_XN), (const bf16*)(ws + WS_WOUT), M, D, D}; pg8::StaticOrder S; S.init(M, D, F.G, (int)blockIdx.x);
        pg8::EpiResBf16 E{fin(F, 0), (bf16*)(ws + WS_X1)};
        pg8::gemm_phase<pg8::EpiResBf16, pg8::StaticOrder, PG8_ALIGN, PG8_SP2>(F.lds, g, S, E);
        if (BOTH(6)) GRID_BAR();
    }

    if (IN(7)) { OPAQUE(); } if (IN(7)) REPF(7) { F.ln2_g = fin(F, 8); F.w_rg = fin(F, 9); F.b_rg = fin(F, 10); F.w_re = fin(F, 11); F.b_re = fin(F, 12); router_phase(F); if (BOTH(7)) GRID_BAR(); }

    if (IN(8)) { OPAQUE(); } if (IN(8)) REPF(8) { F.ln2_g = fin(F, 8); sort_gather_phase(F); if (BOTH(8)) GRID_BAR(); }

    if (IN(9) || IN(10)) {
        LAS int* tp = (LAS int*)(F.lds + LDSCTL_OFF);
        if (F.tid <= 16) tp[F.tid] = ((const int*)(ws + WS_SMALL + SM_META))[F.tid];
        __syncthreads();
    }
    if (IN(9)) REPF(9) {
        const LAS int* tp = (const LAS int*)(F.lds + LDSCTL_OFF);
        pg8::Gemm g{(const bf16*)(ws + WS_TS), (const bf16*)(ws + WS_W1), MOE_ROWS, NEXP * 1024, D}; pg8::MoeOrder S{tp[16] * 4, F.G, (int)blockIdx.x, tp};
        pg8::EpiMoeUp E{(bf16*)(ws + WS_H)};
        pg8::gemm_phase<pg8::EpiMoeUp, pg8::MoeOrder, PG8_ALIGN, true, true>(F.lds, g, S, E, (const int*)(ws + WS_SMALL + SM_ROWTOK));
        if (BOTH(9)) GRID_BAR();
    }
    if (IN(10)) REPF(10) {
        const LAS int* tp = (const LAS int*)(F.lds + LDSCTL_OFF);
        pg8::Gemm g{(const bf16*)(ws + WS_H), (const bf16*)(ws + WS_WD), MOE_ROWS, NEXP * 1024, DEXP}; pg8::MoeOrder S{tp[16] * 4, F.G, (int)blockIdx.x, tp};
        pg8::EpiMoeDown E{(const int*)(ws + WS_SMALL + SM_ROWTOK), (const float*)(ws + WS_SMALL + SM_ROWW), (bf16*)(ws + WS_XN), (bf16*)(ws + WS_Y1)};
        pg8::gemm_phase<pg8::EpiMoeDown, pg8::MoeOrder, PG8_ALIGN, PG8_SP2>(F.lds, g, S, E);
        if (BOTH(10)) GRID_BAR();
    }

    if (IN(11)) { OPAQUE(); } if (IN(11)) { F.final_g = fin(F, 16); final_phase(F); }
#ifdef PROBE_A0
    {
        asm volatile("s_waitcnt vmcnt(0)" ::: "memory"); __syncthreads(); TS_MARK(23);
        if ((int)blockIdx.x == (PROBE_BLK) && threadIdx.x == 0) { volatile LAS unsigned long long* T = (volatile LAS unsigned long long*)(F.lds + LDSCTL_OFF + 1024);
            unsigned long long dA = T[PROBE_A1] - T[PROBE_A0]; const unsigned long long dB = T[PROBE_B1] - T[PROBE_B0];
#ifdef PROBE_WAITMASK
            dA = 0ull; for (int k = 0; k < 11; ++k) if (((PROBE_WAITMASK) >> k) & 1) dA += T[2 + 2 * k] - T[1 + 2 * k];
#endif
            const unsigned long long extra = dA * (PROBE_WA) + ((dB + 50ull) / 100ull) * (100ull * (PROBE_QB)) + (PROBE_CT);
            const unsigned long long t0 = __builtin_amdgcn_s_memrealtime();
            while (__builtin_amdgcn_s_memrealtime() - t0 < extra) __builtin_amdgcn_s_sleep(8); }
    }
#endif
    if (N_LAUNCHES == 1 && threadIdx.x == 0) {
        unsigned* bw = g_grid_barrier;
        if (xb_add(&bw[XB_EXIT], 1u) == (unsigned)gridDim.x - 1u) {
            for (unsigned j = 0; j < 16; ++j) { __hip_atomic_store(&bw[XB_XCNT(j)], 0u, RLX_AGENT); __hip_atomic_store(&bw[XB_XSUB(j)], 0u, RLX_AGENT); __hip_atomic_store(&bw[XB_XGEN(j)], 0u, RLX_AGENT); }
            __hip_atomic_store(&bw[XB_TOP], 0u, RLX_AGENT); __hip_atomic_store(&bw[XB_TOPGEN], 0u, RLX_AGENT); __hip_atomic_store(&bw[XB_TMO], 0u, RLX_AGENT); __hip_atomic_store(&bw[XB_EXIT], 0u, RLX_AGENT);
        }
    }
#undef IN
#undef BOTH
#undef GRID_BAR
}

extern "C" void kernel_launch(void* const* d_in, const int* in_sizes, int n_in, void* d_out, int out_size, void* d_ws, size_t ws_size, hipStream_t stream) {
    static int grid = 0;
    if (grid == 0) {
        if (n_in != 17 || in_sizes[0] != M * D || out_size != M * D || ws_size < WS_END) { fprintf(stderr, "kernel_launch: unexpected shapes (n_in %d, in0 %d, out %d, ws %zu); nothing launched\n", n_in, n_in > 0 ? in_sizes[0] : -1, out_size, ws_size); grid = -1; return; }
        int dev = 0, cus = 0, per_cu = 0;
        if (hipGetDevice(&dev) != hipSuccess || hipDeviceGetAttribute(&cus, hipDeviceAttributeMultiprocessorCount, dev) != hipSuccess) { grid = -1; return; }
        if (hipFuncSetAttribute((const void*)hybrid_fwd, hipFuncAttributeMaxDynamicSharedMemorySize, LDS_BYTES) != hipSuccess) { fprintf(stderr, "kernel_launch: hipFuncSetAttribute failed\n"); grid = -1; return; }
        if (hipOccupancyMaxActiveBlocksPerMultiprocessor(&per_cu, (const void*)hybrid_fwd, NWAVES * 64, LDS_BYTES) != hipSuccess || per_cu < 1)
            fprintf(stderr, "kernel_launch: note: occupancy query reports %d workgroups per CU\n", per_cu);
        (void)hipGetLastError();
        grid = cus;
    }
    if (grid < 0) return;
    Args a{};
    for (int i = 0; i < 17; ++i) a.in[i] = (const float*)d_in[i];
    a.out = (float*)d_out; a.ws = (unsigned char*)d_ws;
    if (N_LAUNCHES == 1) {
        a.ph_lo = 0; a.ph_hi = N_PHASES; a.li = 0;
        hipLaunchKernelGGL(hybrid_fwd, dim3(grid), dim3(NWAVES * 64), LDS_BYTES, stream, a);
    } else {
        for (int li = 0; li < N_PHASES; ++li) { a.ph_lo = li; a.ph_hi = li + 1; a.li = li; hipLaunchKernelGGL(hybrid_fwd, dim3(grid), dim3(NWAVES * 64), LDS_BYTES, stream, a); }
    }
}
```
